# Optimizing an MI355X kernel written in HIP

```python
import jax, jax.numpy as jnp
from jax import lax
import numpy as np

D_MODEL = 2048
BATCH = 32
SEQ = 256
DEPTH = 4
DEC_BATCH = 8
DEC_SEQ = 4096
PAST_LEN = 512

GRID_W = 64
N_MIXERS = 3
N_A_LAYERS = (DEPTH + 2) // 3
N_B_LAYERS = (DEPTH + 1) // 3
N_C_LAYERS = DEPTH // 3
CHUNK = 128
A_WIDTH = D_MODEL
A_GROUPS = 8
A_GROUP_DIM = A_WIDTH // A_GROUPS
HEAD_DIM = 128
N_Q_HEADS = D_MODEL // HEAD_DIM
N_KV_HEADS = 4
Q_PER_KV = N_Q_HEADS // N_KV_HEADS
Q_BLOCK = 128
ROPE_THETA = 10000.0
ROPE_AXIS_DIM = HEAD_DIM // 2
POOL_WINDOWS = (2, 4, 8, 16)
POOL_GROUP_DIM = D_MODEL // len(POOL_WINDOWS)
FFN_HIDDEN = -(-8 * D_MODEL // (3 * 256)) * 256
N_MOD = 6
EPS = 1e-6

kernel_name = 'hybrid_diffusion_prefix_trunk_step'


def _rms(x, g):
    xf = x.astype(jnp.float32)
    y = xf * lax.rsqrt(jnp.mean(xf * xf, axis=-1, keepdims=True) + EPS)
    return (y * g.astype(jnp.float32)).astype(x.dtype)


def _swiglu(h, w_gu, w_down):
    gu = h @ w_gu
    g, u = gu[..., :FFN_HIDDEN], gu[..., FFN_HIDDEN:]
    return (jax.nn.silu(g) * u) @ w_down


def _chunk_gmlp(h, w_in, g_v, w_s, b_s, w_out):
    B, T, _ = h.shape
    a = h @ w_in
    u, v = a[..., :A_WIDTH], a[..., A_WIDTH:]
    v = _rms(v, g_v).reshape(B, T // CHUNK, CHUNK, A_GROUPS, A_GROUP_DIM)
    s = jnp.einsum('gpq,bnqge->bnpge', w_s, v) + b_s.T[None, None, :, :, None]
    return (u * s.reshape(B, T, A_WIDTH)) @ w_out


def _pool_mixer(h, w_pool, scale):
    B, T, D = h.shape
    hf = h.astype(jnp.float32)
    cs = jnp.concatenate([jnp.zeros((B, 1, D), jnp.float32), jnp.cumsum(hf, axis=1)], axis=1)
    t = jnp.arange(T)
    outs = []
    for j, w in enumerate(POOL_WINDOWS):
        lo = jnp.clip(t - w // 2, 0, T)
        hi = jnp.clip(t + w // 2, 0, T)
        sl = slice(j * POOL_GROUP_DIM, (j + 1) * POOL_GROUP_DIM)
        cnt = (hi - lo).astype(jnp.float32)[None, :, None]
        outs.append((cs[:, hi, sl] - cs[:, lo, sl]) / cnt - hf[:, :, sl])
    p = jnp.stack(outs, axis=2).astype(h.dtype)
    y = jnp.einsum('btgc,gcd->btgd', p, w_pool).reshape(B, T, D)
    return y * scale


def _rope_2d(x):
    T = x.shape[1]
    t = jnp.arange(T)
    n_rows = T // GRID_W
    row = jnp.minimum(t // GRID_W, n_rows - 1).astype(jnp.float32)
    col = (t % GRID_W).astype(jnp.float32)
    inv = jnp.power(ROPE_THETA, -jnp.arange(0, ROPE_AXIS_DIM, 2, dtype=jnp.float32) / ROPE_AXIS_DIM)
    ang = jnp.concatenate([row[:, None] * inv, col[:, None] * inv], axis=-1)
    ang = ang.reshape((1, T) + (1,) * (x.ndim - 3) + (HEAD_DIM // 2,))
    cos, sin = jnp.cos(ang), jnp.sin(ang)
    xr = x.astype(jnp.float32).reshape(x.shape[:-1] + (HEAD_DIM // 2, 2))
    x1, x2 = xr[..., 0], xr[..., 1]
    out = jnp.stack([x1 * cos - x2 * sin, x1 * sin + x2 * cos], axis=-1)
    return out.reshape(x.shape).astype(x.dtype)


def _qkv(h, w_qkv, q_norm, k_norm):
    B, T, _ = h.shape
    qkv = h @ w_qkv
    nq, nk = N_Q_HEADS * HEAD_DIM, N_KV_HEADS * HEAD_DIM
    q = qkv[..., :nq].reshape(B, T, N_KV_HEADS, Q_PER_KV, HEAD_DIM)
    k = qkv[..., nq:nq + nk].reshape(B, T, N_KV_HEADS, HEAD_DIM)
    v = qkv[..., nq + nk:].reshape(B, T, N_KV_HEADS, HEAD_DIM)
    return _rms(q, q_norm), _rms(k, k_norm), v


def _attend(q, k, v):
    B, T = q.shape[:2]
    nb = T // Q_BLOCK
    qb = q.reshape(B, nb, Q_BLOCK, N_KV_HEADS, Q_PER_KV, HEAD_DIM).swapaxes(0, 1)
    scale = HEAD_DIM ** -0.5

    def one(qi):
        s = jnp.einsum('bqhgd,bkhd->bhgqk', qi, k).astype(jnp.float32) * scale
        p = jax.nn.softmax(s, axis=-1).astype(v.dtype)
        return jnp.einsum('bhgqk,bkhd->bqhgd', p, v)

    o = lax.map(one, qb)
    return o.swapaxes(0, 1).reshape(B, T, N_Q_HEADS * HEAD_DIM)


def _trunk(x, cond, cache_k, cache_v, p):
    latent = cache_k is not None
    Bc = cond.shape[0]
    ia = ib = ic = 0
    new_k, new_v = [], []
    for l in range(DEPTH):
        mod = (jax.nn.silu(cond) @ p['w_mod'][l] + p['b_mod'][l]).reshape(Bc, 1, N_MOD, D_MODEL)
        h = _rms(x, p['norm_mix_pre'][l]) * (1 + mod[:, :, 1]) + mod[:, :, 0]
        kind = l % N_MIXERS
        if kind == 0:
            m = _chunk_gmlp(h, p['a_w_in'][ia], p['a_norm_v'][ia], p['a_w_s'][ia], p['a_b_s'][ia], p['a_w_out'][ia])
            ia += 1
        elif kind == 1:
            q, k, v = _qkv(h, p['b_w_qkv'][ib], p['b_q_norm'][ib], p['b_k_norm'][ib])
            if latent:
                q, k = _rope_2d(q), _rope_2d(k)
                k_all = jnp.concatenate([k, cache_k[:, ib].astype(k.dtype)], axis=1)
                v_all = jnp.concatenate([v, cache_v[:, ib].astype(v.dtype)], axis=1)
                o = _attend(q, k_all, v_all)
            else:
                new_k.append(k)
                new_v.append(v)
                o = _attend(q, k, v)
            m = o @ p['b_w_o'][ib]
            ib += 1
        else:
            m = _pool_mixer(h, p['c_w_pool'][ic], p['c_scale'][ic])
            ic += 1
        x = x + mod[:, :, 2] * _rms(m, p['norm_mix_post'][l])
        h = _rms(x, p['norm_ffn_pre'][l]) * (1 + mod[:, :, 4]) + mod[:, :, 3]
        f = _swiglu(h, p['f_w_gu'][l], p['f_w_down'][l])
        x = x + mod[:, :, 5] * _rms(f, p['norm_ffn_post'][l])
    if latent:
        return x, None, None
    return x, jnp.stack(new_k, axis=1), jnp.stack(new_v, axis=1)


def setup_inputs(seed: int = 0) -> dict:
    key = jax.random.key(seed)
    ks = jax.random.split(key, 26)
    n = lambda k, shape, s: jax.random.normal(k, shape, jnp.float32) * s
    D = D_MODEL
    qkv_out = (N_Q_HEADS + 2 * N_KV_HEADS) * HEAD_DIM
    kv_shape = (DEC_BATCH, N_B_LAYERS, PAST_LEN, N_KV_HEADS, HEAD_DIM)
    return {
        'x_prompt': n(ks[0], (BATCH, SEQ, D), 1.0),
        'x_sample': n(ks[1], (DEC_BATCH, DEC_SEQ, D), 1.0),
        'cache_k': n(ks[2], kv_shape, 1.0),
        'cache_v': n(ks[3], kv_shape, 1.0),
        'c': n(ks[4], (DEC_BATCH, D), 1.0),
        'c_ctx': n(ks[5], (D,), 1.0),
        'w_mod': n(ks[6], (DEPTH, D, N_MOD * D), D ** -0.5),
        'b_mod': n(ks[7], (DEPTH, N_MOD * D), 0.01),
        'norm_mix_pre': 1.0 + n(ks[8], (DEPTH, D), 0.02),
        'norm_mix_post': 1.0 + n(ks[9], (DEPTH, D), 0.02),
        'norm_ffn_pre': 1.0 + n(ks[10], (DEPTH, D), 0.02),
        'norm_ffn_post': 1.0 + n(ks[11], (DEPTH, D), 0.02),
        'a_w_in': n(ks[12], (N_A_LAYERS, D, 2 * A_WIDTH), D ** -0.5),
        'a_norm_v': 1.0 + n(ks[13], (N_A_LAYERS, A_WIDTH), 0.02),
        'a_w_s': n(ks[14], (N_A_LAYERS, A_GROUPS, CHUNK, CHUNK), CHUNK ** -0.5),
        'a_b_s': 1.0 + n(ks[15], (N_A_LAYERS, A_GROUPS, CHUNK), 0.02),
        'a_w_out': n(ks[16], (N_A_LAYERS, A_WIDTH, D), A_WIDTH ** -0.5),
        'b_w_qkv': n(ks[17], (N_B_LAYERS, D, qkv_out), D ** -0.5),
        'b_q_norm': 1.0 + n(ks[18], (N_B_LAYERS, HEAD_DIM), 0.02),
        'b_k_norm': 1.0 + n(ks[19], (N_B_LAYERS, HEAD_DIM), 0.02),
        'b_w_o': n(ks[20], (N_B_LAYERS, N_Q_HEADS * HEAD_DIM, D), (N_Q_HEADS * HEAD_DIM) ** -0.5),
        'c_w_pool': n(ks[21], (N_C_LAYERS, len(POOL_WINDOWS), POOL_GROUP_DIM, POOL_GROUP_DIM), POOL_GROUP_DIM ** -0.5),
        'c_scale': 1.0 + n(ks[22], (N_C_LAYERS, D), 0.1),
        'f_w_gu': n(ks[23], (DEPTH, D, 2 * FFN_HIDDEN), D ** -0.5),
        'f_w_down': n(ks[24], (DEPTH, FFN_HIDDEN, D), FFN_HIDDEN ** -0.5),
    }


def reference(x_prompt, x_sample, cache_k, cache_v, c, c_ctx, w_mod, b_mod,
              norm_mix_pre, norm_mix_post, norm_ffn_pre, norm_ffn_post,
              a_w_in, a_norm_v, a_w_s, a_b_s, a_w_out,
              b_w_qkv, b_q_norm, b_k_norm, b_w_o,
              c_w_pool, c_scale, f_w_gu, f_w_down):
    p = {
        'w_mod': w_mod, 'b_mod': b_mod,
        'norm_mix_pre': norm_mix_pre, 'norm_mix_post': norm_mix_post,
        'norm_ffn_pre': norm_ffn_pre, 'norm_ffn_post': norm_ffn_post,
        'a_w_in': a_w_in, 'a_norm_v': a_norm_v, 'a_w_s': a_w_s, 'a_b_s': a_b_s, 'a_w_out': a_w_out,
        'b_w_qkv': b_w_qkv, 'b_q_norm': b_q_norm, 'b_k_norm': b_k_norm, 'b_w_o': b_w_o,
        'c_w_pool': c_w_pool, 'c_scale': c_scale, 'f_w_gu': f_w_gu, 'f_w_down': f_w_down,
    }
    y_prompt, state_k, state_v = _trunk(x_prompt, c_ctx[None, :], None, None, p)
    y_sample, _, _ = _trunk(x_sample, c, cache_k, cache_v, p)
    return (y_prompt, y_sample, state_k, state_v)
```

```cpp
#include <hip/hip_runtime.h>
#include <cstdio>
#include <cstdint>

#ifndef MK_ONE_LAUNCH
#define MK_ONE_LAUNCH 1
#endif

#define GAS __attribute__((address_space(1)))
#define LAS __attribute__((address_space(3)))
typedef unsigned short bf16_t;
typedef short bf16x8 __attribute__((ext_vector_type(8)));
typedef short s16x4 __attribute__((ext_vector_type(4)));
typedef float f32x2 __attribute__((ext_vector_type(2)));
typedef float f32x4 __attribute__((ext_vector_type(4)));
typedef float f32x8 __attribute__((ext_vector_type(8)));
typedef float f32x16 __attribute__((ext_vector_type(16)));
typedef unsigned u32x2 __attribute__((ext_vector_type(2)));
typedef unsigned u32x4 __attribute__((ext_vector_type(4)));

constexpr int DM = 2048, FFH = 5632, NCTX = 8192, NLAT = 32768, MTOK = NCTX + NLAT;
constexpr int LAT_B = 8, LAT_T = 4096, PAST = 512, KV_T = LAT_T + PAST;
constexpr int KVROWS = NCTX + LAT_B * KV_T;
constexpr int NCOND = 9, NMOD = 6, MODW = NMOD * DM;
constexpr float EPS = 1e-6f;
constexpr int NWAVES = 8, NTHR = 512;
constexpr size_t OUT_SK = (size_t)MTOK * DM, OUT_SV = OUT_SK + (size_t)NCTX * 512;

constexpr size_t MiB = 1u << 20;
constexpr size_t WS_CTL = 0, CTL_ZERO_BYTES = 1 * MiB;
constexpr size_t WS_MODP = 1 * MiB;
constexpr size_t WS_MOD = 15 * MiB;
constexpr size_t WS_ROPE = 17 * MiB;
constexpr size_t WS_VSS = 18 * MiB;
constexpr size_t WS_WGU = 32 * MiB;
constexpr size_t WS_WDN = 208 * MiB;
constexpr size_t WS_WIN = 296 * MiB;
constexpr size_t WS_WOUT = 328 * MiB;
constexpr size_t WS_WQKV = 344 * MiB;
constexpr size_t WS_WO = 356 * MiB;
constexpr size_t WS_WPOOL = 364 * MiB;
constexpr size_t WS_H = 368 * MiB;
constexpr size_t WS_MB = 528 * MiB;
constexpr size_t WS_BIG = 688 * MiB;
constexpr size_t WS_KB = 1128 * MiB;
constexpr size_t WS_VB = 1172 * MiB;
constexpr size_t WS_XB = 1216 * MiB;
constexpr size_t WS_END = 1376 * MiB;
constexpr size_t BIG_V = 160 * MiB, BIG_KR = 160 * MiB, BIG_VR = 200 * MiB;
constexpr int CW_TMO = 0, CW_BAR = 4096;

constexpr int RING_BYTES = 131072;
constexpr int LDS_BYTES = 147456;
constexpr int MISC_OFF = LDS_BYTES - 256;

template <int CTRL> __device__ __forceinline__ float dpp_get(float v) { return __builtin_bit_cast(float, __builtin_amdgcn_update_dpp(0, __builtin_bit_cast(int, v), CTRL, 0xf, 0xf, true)); }
__device__ __forceinline__ float row16_sum(float v) { v += dpp_get<0xB1>(v); v += dpp_get<0x4E>(v); v += dpp_get<0x141>(v); v += dpp_get<0x140>(v); return v; }
__device__ __forceinline__ float wave_sum(float v) {
    v = row16_sum(v);
    const float a = __builtin_bit_cast(float, __builtin_amdgcn_readlane(__builtin_bit_cast(int, v), 0)), b = __builtin_bit_cast(float, __builtin_amdgcn_readlane(__builtin_bit_cast(int, v), 16));
    const float c = __builtin_bit_cast(float, __builtin_amdgcn_readlane(__builtin_bit_cast(int, v), 32)), d = __builtin_bit_cast(float, __builtin_amdgcn_readlane(__builtin_bit_cast(int, v), 48));
    return (a + b) + (c + d);
}
__device__ __forceinline__ unsigned cvt_pk_bf16(float lo, float hi) { unsigned r; asm volatile("v_cvt_pk_bf16_f32 %0, %1, %2" : "=v"(r) : "v"(lo), "v"(hi)); return r; }
__device__ __forceinline__ float bflo(unsigned w) { return __builtin_bit_cast(float, w << 16); }
__device__ __forceinline__ float bfhi(unsigned w) { return __builtin_bit_cast(float, w & 0xffff0000u); }
__device__ __forceinline__ unsigned short f2bf(float f) { unsigned u = __builtin_bit_cast(unsigned, f); return (unsigned short)((u + 0x7fffu + ((u >> 16) & 1u)) >> 16); }
__device__ __forceinline__ float silu_f(float g) { return g * __builtin_amdgcn_rcpf(1.0f + __builtin_amdgcn_exp2f(-1.4426950408889634f * g)); }

namespace pg8 {
constexpr int BM = 256, BK = 64, HALF = 128, HTB = HALF * BK * 2, STAGE_BYTES = 8 * HTB, NXCD = 8, WGM = 8;
__host__ __device__ __forceinline__ int lds_byte(int r, int c) { const int st = (r >> 4) * 2 + (c >> 5), rr = r & 15, cc = c & 31, ob = rr * 64 + cc * 2; return st * 1024 + (ob ^ (((ob >> 9) & 1) << 5)); }
__host__ __device__ __forceinline__ void stage_rc(int b, int& R, int& C) { const int st = b / 1024, sb = b % 1024, swz = sb ^ (((sb >> 9) & 1) << 5); R = (st >> 1) * 16 + swz / 64; C = (st & 1) * 32 + (swz % 64) / 2; }
__host__ __device__ __forceinline__ int perm32(int rho) { const int n = rho >> 4, i = rho & 15; return 8 * (i >> 2) + 4 * n + (i & 3); }

struct Unit { int pm, pn; };
struct Gemm { const bf16_t* A; const bf16_t* Bt; int lda, ldb, K, gshift; };

struct StaticOrder {
    int nM, nN, nwg, G, c, wgm;
    __host__ __device__ void init(int M, int N, int G_, int c_, int wgm_ = WGM) { nM = M / BM; nN = N / BM; nwg = nM * nN; G = G_; c = c_; wgm = wgm_; }
    __host__ __device__ bool next(int i, Unit& u) const {
        const long L = (long)i * G + c; if (L >= nwg) return false;
        int wgid = (int)L; { const int q = nwg / NXCD, r = nwg % NXCD, xcd = wgid % NXCD, off = wgid / NXCD; wgid = (xcd < r ? xcd * (q + 1) : r * (q + 1) + (xcd - r) * q) + off; }
        const int nig = wgm * nN, gid = wgid / nig, fm = gid * wgm, gsz = (nM - fm) < wgm ? (nM - fm) : wgm;
        u.pm = fm + ((wgid % nig) % gsz); u.pn = (wgid % nig) / gsz; return true;
    }
};

struct EpiM {
    bf16_t* O; int ldc; const float* cscale;
    __device__ __forceinline__ void operator()(const f32x4 (&acc)[2][2][4][2], const Unit& u, int wr, int wc, int fr, int fq) const {
        const int row0 = u.pm * BM + wr * 64 + fr, col0 = u.pn * BM + wc * 32 + 8 * fq;
        f32x4 sv[2][2];
#pragma unroll
        for (int bj = 0; bj < 2; ++bj)
#pragma unroll
            for (int n = 0; n < 2; ++n) sv[bj][n] = cscale ? *(const f32x4*)(cscale + col0 + bj * HALF + 4 * n) : (f32x4){1.f, 1.f, 1.f, 1.f};
#pragma unroll
        for (int ai = 0; ai < 2; ++ai)
#pragma unroll
            for (int m = 0; m < 4; ++m) { bf16_t* rowp = O + (size_t)(row0 + ai * HALF + m * 16) * ldc + col0;
#pragma unroll
                for (int bj = 0; bj < 2; ++bj) { const f32x4 v0 = acc[ai][bj][m][0] * sv[bj][0], v1 = acc[ai][bj][m][1] * sv[bj][1];
                    u32x4 w; w.x = cvt_pk_bf16(v0[0], v0[1]); w.y = cvt_pk_bf16(v0[2], v0[3]); w.z = cvt_pk_bf16(v1[0], v1[1]); w.w = cvt_pk_bf16(v1[2], v1[3]);
                    *(u32x4*)(rowp + bj * HALF) = w; } }
    }
};
struct EpiUV {
    bf16_t* U; bf16_t* V; float* vss;
    __device__ __forceinline__ void operator()(const f32x4 (&acc)[2][2][4][2], const Unit& u, int wr, int wc, int fr, int fq) const {
        const bool isv = u.pn >= 8;
        const int row0 = u.pm * BM + wr * 64 + fr, col0 = (u.pn & 7) * BM + wc * 32 + 8 * fq;
        bf16_t* base = isv ? V : U;
#pragma unroll
        for (int ai = 0; ai < 2; ++ai)
#pragma unroll
            for (int m = 0; m < 4; ++m) { const int row = row0 + ai * HALF + m * 16; bf16_t* rowp = base + (size_t)row * DM + col0; float ss = 0.f;
#pragma unroll
                for (int bj = 0; bj < 2; ++bj) { const f32x4 v0 = acc[ai][bj][m][0], v1 = acc[ai][bj][m][1];
                    ss += (v0[0] * v0[0] + v0[1] * v0[1]) + (v0[2] * v0[2] + v0[3] * v0[3]) + (v1[0] * v1[0] + v1[1] * v1[1]) + (v1[2] * v1[2] + v1[3] * v1[3]);
                    u32x4 w; w.x = cvt_pk_bf16(v0[0], v0[1]); w.y = cvt_pk_bf16(v0[2], v0[3]); w.z = cvt_pk_bf16(v1[0], v1[1]); w.w = cvt_pk_bf16(v1[2], v1[3]);
                    *(u32x4*)(rowp + bj * HALF) = w; }
                if (isv) { ss += __shfl_xor(ss, 16); ss += __shfl_xor(ss, 32); if (fq == 0) vss[(size_t)row * 32 + (u.pn - 8) * 4 + wc] = ss; } }
    }
};
struct EpiQKV {
    bf16_t* Q; bf16_t* Kr; bf16_t* Vb; float* sv;
    __device__ __forceinline__ void operator()(const f32x4 (&acc)[2][2][4][2], const Unit& u, int wr, int wc, int fr, int fq) const {
        bf16_t* base; int ldc, ct; int radd = 0; const bool isv = u.pn >= 10, ctx = u.pm < 32;
        if (u.pn < 8) { base = Q; ldc = DM; ct = u.pn; } else if (u.pn < 10) { base = Kr; ldc = 512; ct = u.pn - 8; } else { base = Vb; ldc = 512; ct = u.pn - 10; radd = ctx ? 0 : ((u.pm - 32) >> 4) * 512; }
        const int row0 = u.pm * BM + wr * 64 + fr, col0 = ct * BM + wc * 32 + 8 * fq;
#pragma unroll
        for (int ai = 0; ai < 2; ++ai)
#pragma unroll
            for (int m = 0; m < 4; ++m) { const int row = row0 + ai * HALF + m * 16; bf16_t* rowp = base + (size_t)(row + radd) * ldc + col0;
#pragma unroll
                for (int bj = 0; bj < 2; ++bj) { const f32x4 v0 = acc[ai][bj][m][0], v1 = acc[ai][bj][m][1];
                    u32x4 w; w.x = cvt_pk_bf16(v0[0], v0[1]); w.y = cvt_pk_bf16(v0[2], v0[3]); w.z = cvt_pk_bf16(v1[0], v1[1]); w.w = cvt_pk_bf16(v1[2], v1[3]);
                    *(u32x4*)(rowp + bj * HALF) = w;
                    if (isv && ctx) { float* sp = sv + (size_t)row * 512 + col0 + bj * HALF; *(f32x4*)sp = v0; *(f32x4*)(sp + 4) = v1; } } }
    }
};
struct EpiSwiglu {
    bf16_t* O; int ldc;
    __device__ __forceinline__ void operator()(const f32x4 (&acc)[2][2][4][2], const Unit& u, int wr, int wc, int fr, int fq) const {
        const int row0 = u.pm * BM + wr * 64 + fr, col0 = u.pn * HALF + wc * 32 + 8 * fq;
#pragma unroll
        for (int ai = 0; ai < 2; ++ai)
#pragma unroll
            for (int m = 0; m < 4; ++m) { bf16_t* rowp = O + (size_t)(row0 + ai * HALF + m * 16) * ldc + col0;
                const f32x4 g0 = acc[ai][0][m][0], g1 = acc[ai][0][m][1], u0 = acc[ai][1][m][0], u1 = acc[ai][1][m][1];
                u32x4 w;
                w.x = cvt_pk_bf16(silu_f(g0[0]) * u0[0], silu_f(g0[1]) * u0[1]); w.y = cvt_pk_bf16(silu_f(g0[2]) * u0[2], silu_f(g0[3]) * u0[3]);
                w.z = cvt_pk_bf16(silu_f(g1[0]) * u1[0], silu_f(g1[1]) * u1[1]); w.w = cvt_pk_bf16(silu_f(g1[2]) * u1[2], silu_f(g1[3]) * u1[3]);
                *(u32x4*)rowp = w; }
    }
};

template <class Epi, class Sched>
__device__ __forceinline__ void gemm_phase(LAS unsigned char* lds, const Gemm g, const Sched& S, const Epi& E, const int tid) {
    const int wid = __builtin_amdgcn_readfirstlane(tid >> 6), lane = tid & 63, wr = wid >> 2, wc = wid & 3, fr = lane & 15, fq = lane >> 4;
    const int K = g.K, nt = K / BK;
    unsigned voffA[2], voffB[2];
#pragma unroll
    for (int i = 0; i < 2; ++i) { int R, C; stage_rc(tid * 16 + i * 8192, R, C); const int Rb = (R & ~31) + perm32(R & 31);
        voffA[i] = (unsigned)(R * g.lda + C) * 2u; voffB[i] = (unsigned)(Rb * g.ldb + C) * 2u; }
    const size_t kstep = (size_t)(BK * 2);
    const size_t hstepA = (size_t)HALF * g.lda * 2, hstepB = (size_t)HALF * g.ldb * 2;
    const unsigned ldsw = (unsigned)wid * 1024u;
    const int aoff = lds_byte(wr * 64 + fr, fq * 8), boff = lds_byte(wc * 32 + fr, fq * 8);
#define PG8_UA(u) ((const char*)g.A + (size_t)(u).pm * (2 * hstepA) + (size_t)((u).pn >> g.gshift) * (size_t)K * 2)
#define PG8_UB(u) ((const char*)g.Bt + (size_t)(u).pn * (2 * hstepB))
#define PG8_SA(b, h) (((b) * 2 + (h)) * HTB)
#define PG8_SB(b, h) ((4 + (b) * 2 + (h)) * HTB)
#define PG8_STAGE(bufoff, gbase, voff) do { _Pragma("unroll") for (int _i = 0; _i < 2; ++_i) \
        __builtin_amdgcn_global_load_lds((const unsigned*)((const char*)(gbase) + (voff)[_i]), (LAS unsigned*)(lds + (bufoff) + ldsw + _i * 8192), 16, 0, 0); } while (0)
#define PG8_LDA(dst, b, h) do { _Pragma("unroll") for (int m = 0; m < 4; ++m) _Pragma("unroll") for (int k = 0; k < 2; ++k) dst[m][k] = *(const LAS bf16x8*)(lds + PG8_SA(b, h) + aoff + m * 2048 + k * 1024); } while (0)
#define PG8_LDB(dst, b, h) do { _Pragma("unroll") for (int n = 0; n < 2; ++n) _Pragma("unroll") for (int k = 0; k < 2; ++k) dst[n][k] = *(const LAS bf16x8*)(lds + PG8_SB(b, h) + boff + n * 2048 + k * 1024); } while (0)
#define PG8_MMA(ai, bj, At, Bt) do { __builtin_amdgcn_s_setprio(1); _Pragma("unroll") for (int m = 0; m < 4; ++m) _Pragma("unroll") for (int n = 0; n < 2; ++n) _Pragma("unroll") for (int k = 0; k < 2; ++k) \
        acc[ai][bj][m][n] = __builtin_amdgcn_mfma_f32_16x16x32_bf16(Bt[n][k], At[m][k], acc[ai][bj][m][n], 0, 0, 0); __builtin_amdgcn_s_setprio(0); } while (0)
#define PG8_WAIT_V(n) asm volatile("s_waitcnt vmcnt(" #n ")" ::: "memory")
#define PG8_WAIT_L(n) asm volatile("s_waitcnt lgkmcnt(" #n ")" ::: "memory")
#define PG8_BAR __builtin_amdgcn_s_barrier()
#define PG8_SCHED __builtin_amdgcn_sched_barrier(0)
    Unit cur, nxt; int ui = 0;
    if (!S.next(0, cur)) return;
    f32x4 acc[2][2][4][2];
#pragma unroll
    for (int a = 0; a < 2; ++a)
#pragma unroll
        for (int b = 0; b < 2; ++b)
#pragma unroll
            for (int m = 0; m < 4; ++m)
#pragma unroll
                for (int n = 0; n < 2; ++n) acc[a][b][m][n] = (f32x4){0.f, 0.f, 0.f, 0.f};
    bf16x8 At[4][2], B0[2][2], B1[2][2];
    const char* cA = PG8_UA(cur); const char* cB = PG8_UB(cur);
    PG8_STAGE(PG8_SB(0, 0), cB, voffB); PG8_STAGE(PG8_SB(0, 1), cB + hstepB, voffB); PG8_STAGE(PG8_SA(0, 0), cA, voffA); PG8_STAGE(PG8_SA(0, 1), cA + hstepA, voffA);
    if (wr == 1) PG8_BAR;
    PG8_WAIT_V(2); PG8_BAR;
    PG8_STAGE(PG8_SB(1, 0), cB + kstep, voffB); PG8_STAGE(PG8_SA(1, 0), cA + kstep, voffA); PG8_STAGE(PG8_SB(1, 1), cB + hstepB + kstep, voffB);
    PG8_WAIT_V(6); PG8_BAR;
    for (;;) {
        const bool has_next = S.next(ui + 1, nxt);
        const char* nA = has_next ? PG8_UA(nxt) : cA; const char* nB = has_next ? PG8_UB(nxt) : cB;
        for (int t = 0; t < nt; t += 2) {
            const bool last = (t == nt - 2);
            const char* a1 = cA + (size_t)(t + 1) * kstep;
            const char* a2 = last ? nA : cA + (size_t)(t + 2) * kstep; const char* b2 = last ? nB : cB + (size_t)(t + 2) * kstep;
            const char* a3 = a2 + kstep; const char* b3 = b2 + kstep;
            PG8_LDB(B0, 0, 0); PG8_LDB(B1, 0, 1); PG8_SCHED; PG8_LDA(At, 0, 0); PG8_STAGE(PG8_SA(1, 1), a1 + hstepA, voffA);
            PG8_WAIT_V(8); PG8_WAIT_L(0); PG8_BAR; PG8_MMA(0, 0, At, B0); PG8_MMA(0, 1, At, B1); PG8_BAR; PG8_SCHED;
            PG8_LDA(At, 0, 1); PG8_STAGE(PG8_SB(0, 0), b2, voffB); PG8_STAGE(PG8_SB(0, 1), b2 + hstepB, voffB); PG8_STAGE(PG8_SA(0, 0), a2, voffA);
            PG8_WAIT_V(8); PG8_WAIT_L(0); PG8_BAR; PG8_MMA(1, 0, At, B0); PG8_MMA(1, 1, At, B1); PG8_BAR; PG8_SCHED;
            PG8_LDB(B0, 1, 0); PG8_LDB(B1, 1, 1); PG8_SCHED; PG8_LDA(At, 1, 0); PG8_STAGE(PG8_SA(0, 1), a2 + hstepA, voffA);
            PG8_WAIT_V(8); PG8_WAIT_L(0); PG8_BAR; PG8_MMA(0, 0, At, B0); PG8_MMA(0, 1, At, B1); PG8_BAR; PG8_SCHED;
            PG8_LDA(At, 1, 1); PG8_STAGE(PG8_SB(1, 0), b3, voffB); PG8_STAGE(PG8_SB(1, 1), b3 + hstepB, voffB); PG8_STAGE(PG8_SA(1, 0), a3, voffA);
            PG8_WAIT_V(8); PG8_WAIT_L(0); PG8_BAR; PG8_MMA(1, 0, At, B0); PG8_MMA(1, 1, At, B1); PG8_BAR; PG8_SCHED;
        }
        if (wr == 0) PG8_BAR;
        E(acc, cur, wr, wc, fr, fq);
        if (!has_next) break;
#pragma unroll
        for (int a = 0; a < 2; ++a)
#pragma unroll
            for (int b = 0; b < 2; ++b)
#pragma unroll
                for (int m = 0; m < 4; ++m)
#pragma unroll
                    for (int n = 0; n < 2; ++n) acc[a][b][m][n] = (f32x4){0.f, 0.f, 0.f, 0.f};
        cur = nxt; cA = nA; cB = nB; ++ui;
        if (wr == 1) PG8_BAR;
    }
    PG8_WAIT_V(0);
    PG8_BAR;
#undef PG8_UA
#undef PG8_UB
#undef PG8_SA
#undef PG8_SB
#undef PG8_STAGE
#undef PG8_LDA
#undef PG8_LDB
#undef PG8_MMA
#undef PG8_WAIT_V
#undef PG8_WAIT_L
#undef PG8_BAR
#undef PG8_SCHED
}
}

namespace att {
constexpr int D = 128, NW = 8, QBLK = 32, KVBLK = 64;
constexpr float SCALE = 0.088388347648318440f;
constexpr float THR = 8.f;
constexpr int LDQ = 2048, LDK = 512, LDO = 2048;
constexpr size_t SHM_V = KVBLK * D * 2, SHM_K = KVBLK * D * 2, SHM_ATTN = 2 * SHM_V + 2 * SHM_K + NW * 64 * 4;
#define KSWZ(row, colB) ((row) * 256 + ((colB) ^ (((row) & 7) << 4)))
#define SBAR() __builtin_amdgcn_sched_barrier(0)
__device__ __forceinline__ int crow(int r, int hi) { return (r & 3) + 8 * (r >> 2) + 4 * hi; }
__device__ __forceinline__ unsigned cvtpk(float lo, float hi) { unsigned r; asm volatile("v_cvt_pk_bf16_f32 %0, %1, %2" : "=v"(r) : "v"(lo), "v"(hi)); return r; }
__device__ __forceinline__ bf16x8 ld8(const bf16_t* p) { return *reinterpret_cast<const bf16x8*>(p); }

__device__ __forceinline__ void partialSM(f32x16& p0, f32x16& p1, float& m_reg, f32x16& negm, float& alpha) {
  constexpr float THR2 = THR * 1.4426950408889634f;
  float pmax = p0[0];
#pragma unroll
  for (int r = 1; r < 16; ++r) pmax = fmaxf(pmax, p0[r]);
#pragma unroll
  for (int r = 0; r < 16; ++r) pmax = fmaxf(pmax, p1[r]);
  { auto rr = __builtin_amdgcn_permlane32_swap(__float_as_uint(pmax), __float_as_uint(pmax), false, false);
    pmax = fmaxf(__uint_as_float(rr[0]), __uint_as_float(rr[1])); }
  if (__builtin_expect(__all(pmax <= THR2), 1)) { alpha = 1.f; }
  else { const float d = fmaxf(pmax, 0.f); m_reg += d; alpha = __builtin_amdgcn_exp2f(-d);
#pragma unroll
    for (int r = 0; r < 16; ++r) { p0[r] -= d; p1[r] -= d; }
#pragma unroll
    for (int r = 0; r < 16; ++r) negm[r] = -m_reg;
    asm volatile("" : "+v"(negm)); }
#pragma unroll
  for (int r = 0; r < 16; ++r) p0[r] = __builtin_amdgcn_exp2f(p0[r]);
}
__device__ __forceinline__ void finishSM(f32x16& p0, f32x16& p1, float alpha, float& l_reg, bf16x8& pa0, bf16x8& pa1, bf16x8& pa2, bf16x8& pa3) {
#pragma unroll
  for (int r = 0; r < 16; ++r) p1[r] = __builtin_amdgcn_exp2f(p1[r]);
  f32x2 ps2 = (f32x2){p0[0], p0[1]} + (f32x2){p1[0], p1[1]};
#pragma unroll
  for (int r = 2; r < 16; r += 2) { ps2 += (f32x2){p0[r], p0[r + 1]}; ps2 += (f32x2){p1[r], p1[r + 1]}; }
  float ps = ps2.x + ps2.y;
  { auto rr = __builtin_amdgcn_permlane32_swap(__float_as_uint(ps), __float_as_uint(ps), false, false);
    ps = __uint_as_float(rr[0]) + __uint_as_float(rr[1]); }
  l_reg = l_reg * alpha + ps;
#define PK4(P, BASE, OUT) do { unsigned a0 = cvtpk(P[BASE + 0], P[BASE + 1]), a1 = cvtpk(P[BASE + 2], P[BASE + 3]);   \
    unsigned b0 = cvtpk(P[BASE + 4], P[BASE + 5]), b1 = cvtpk(P[BASE + 6], P[BASE + 7]);                              \
    auto r0 = __builtin_amdgcn_permlane32_swap(a0, b0, false, false); auto r1 = __builtin_amdgcn_permlane32_swap(a1, b1, false, false); \
    u32x4 w = {r0[0], r1[0], r0[1], r1[1]}; OUT = *reinterpret_cast<bf16x8*>(&w); } while (0)
  PK4(p0, 0, pa0); PK4(p0, 8, pa1); PK4(p1, 0, pa2); PK4(p1, 8, pa3);
#undef PK4
}
__device__ __forceinline__ void qkt(f32x16& p0, f32x16& p1, const LAS char* Ks, const bf16x8* qr, const f32x16& negm, int r32, int hi) {
#pragma unroll
  for (int dl = 0; dl < 4; ++dl) { const LAS char* kb_ = Ks + KSWZ(r32, (dl * 16 + hi * 8) * 2);
#pragma unroll
    for (int dh = 0; dh < 2; ++dh) { const int d0 = dl + 4 * dh;
      bf16x8 b0 = *(const LAS bf16x8*)(kb_ + dh * 128);
      bf16x8 b1 = *(const LAS bf16x8*)(kb_ + dh * 128 + 8192);
      if (dl == 0 && dh == 0) { p0 = __builtin_amdgcn_mfma_f32_32x32x16_bf16(b0, qr[d0], negm, 0, 0, 0); p1 = __builtin_amdgcn_mfma_f32_32x32x16_bf16(b1, qr[d0], negm, 0, 0, 0); }
      else { p0 = __builtin_amdgcn_mfma_f32_32x32x16_bf16(b0, qr[d0], p0, 0, 0, 0); p1 = __builtin_amdgcn_mfma_f32_32x32x16_bf16(b1, qr[d0], p1, 0, 0, 0); } } }
}
__device__ __forceinline__ int v_st(int k, int c) { const int kk = (k & ~0xC) | ((k & 4) << 1) | ((k & 8) >> 1); return ((kk >> 3) * 4 + (c >> 5)) * 512 + ((kk & 7) * 32 + (c & 31)) * 2; }
__device__ __forceinline__ int v_rd_base(int lane) { return ((lane & 3) << 3) | (((lane >> 2) & 3) << 6) | (((lane >> 4) & 1) << 5) | (((lane >> 5) & 1) << 8); }
constexpr int v_rd_off(int d0, int ks, int half) { return d0 * 512 + ks * 4096 + half * 2048; }
template <int OFF> __device__ __forceinline__ s16x4 tr_read(int vb) {
  s16x4 r; asm volatile("ds_read_b64_tr_b16 %0, %1 offset:%2" : "=&v"(r) : "v"(vb), "i"(OFF) : "memory"); return r;
}
template <int D0> __device__ __forceinline__ void pv_one(f32x16& od, int vb, bf16x8 pa0, bf16x8 pa1, bf16x8 pa2, bf16x8 pa3) {
  const s16x4 l0 = tr_read<v_rd_off(D0, 0, 0)>(vb), h0 = tr_read<v_rd_off(D0, 0, 1)>(vb), l1 = tr_read<v_rd_off(D0, 1, 0)>(vb), h1 = tr_read<v_rd_off(D0, 1, 1)>(vb);
  const s16x4 l2 = tr_read<v_rd_off(D0, 2, 0)>(vb), h2 = tr_read<v_rd_off(D0, 2, 1)>(vb), l3 = tr_read<v_rd_off(D0, 3, 0)>(vb), h3 = tr_read<v_rd_off(D0, 3, 1)>(vb);
  asm volatile("s_waitcnt lgkmcnt(0)" ::: "memory"); SBAR();
#define PK(L, H) (bf16x8){L[0], L[1], L[2], L[3], H[0], H[1], H[2], H[3]}
  od = __builtin_amdgcn_mfma_f32_32x32x16_bf16(pa0, PK(l0, h0), od, 0, 0, 0);
  od = __builtin_amdgcn_mfma_f32_32x32x16_bf16(pa1, PK(l1, h1), od, 0, 0, 0);
  od = __builtin_amdgcn_mfma_f32_32x32x16_bf16(pa2, PK(l2, h2), od, 0, 0, 0);
  od = __builtin_amdgcn_mfma_f32_32x32x16_bf16(pa3, PK(l3, h3), od, 0, 0, 0);
#undef PK
}
__device__ __forceinline__ void pv_d0(f32x16* o, int vb, bf16x8 pa0, bf16x8 pa1, bf16x8 pa2, bf16x8 pa3) {
  pv_one<0>(o[0], vb, pa0, pa1, pa2, pa3); pv_one<1>(o[1], vb, pa0, pa1, pa2, pa3); pv_one<2>(o[2], vb, pa0, pa1, pa2, pa3); pv_one<3>(o[3], vb, pa0, pa1, pa2, pa3);
}

__device__ __forceinline__ void attn_dense_body(const bf16_t* __restrict__ Qb, const bf16_t* __restrict__ Kh, const bf16_t* __restrict__ Vh, bf16_t* __restrict__ Ob, int seq, LAS char* lds, const int tid, const float* __restrict__ qn, const f32x2* __restrict__ rope, const int t0  ) {
  const int wid = tid >> 6, lane = tid & 63, r32 = lane & 31, hi = lane >> 5;
  LAS char* V_lds = lds; LAS char* K_lds = lds + 2 * SHM_V;
  LAS float* ws = (LAS float*)(lds + 2 * SHM_V + 2 * SHM_K) + wid * 64; LAS float* li_l = ws; LAS float* al_l = ws + 32;
  float m_reg = 0.f, l_reg = 0; f32x16 o[4] = {}; bf16x8 qr[8]; f32x16 negm = {}; asm volatile("" : "+v"(negm));
  const bf16_t* Qw = Qb + (long)(wid * QBLK + r32) * LDQ + hi * 8;
#pragma unroll
  for (int d0 = 0; d0 < 8; ++d0) qr[d0] = ld8(Qw + d0 * 16);
  {
    float ss = 0.f;
#pragma unroll
    for (int d0 = 0; d0 < 8; ++d0) { const u32x4 w = __builtin_bit_cast(u32x4, qr[d0]);
      const float a0 = bflo(w.x), a1 = bfhi(w.x), a2 = bflo(w.y), a3 = bfhi(w.y), a4 = bflo(w.z), a5 = bfhi(w.z), a6 = bflo(w.w), a7 = bfhi(w.w);
      ss += (a0 * a0 + a1 * a1) + (a2 * a2 + a3 * a3) + (a4 * a4 + a5 * a5) + (a6 * a6 + a7 * a7); }
    { auto rr = __builtin_amdgcn_permlane32_swap(__float_as_uint(ss), __float_as_uint(ss), false, false); ss = __uint_as_float(rr[0]) + __uint_as_float(rr[1]); }
    const float rstd = (SCALE * 1.4426950408889634f) / sqrtf(ss * (1.0f / 128.0f) + 1e-6f);
    const int t = t0 + wid * QBLK + r32, prow = t >> 6, pcol = t & 63;
#pragma unroll
    for (int d0 = 0; d0 < 8; ++d0) { const u32x4 w = __builtin_bit_cast(u32x4, qr[d0]);
      const f32x4 g0 = *(const f32x4*)(qn + d0 * 16 + hi * 8), g1 = *(const f32x4*)(qn + d0 * 16 + hi * 8 + 4);
      float y0 = bflo(w.x) * rstd * g0[0], y1 = bfhi(w.x) * rstd * g0[1], y2 = bflo(w.y) * rstd * g0[2], y3 = bfhi(w.y) * rstd * g0[3];
      float y4 = bflo(w.z) * rstd * g1[0], y5 = bfhi(w.z) * rstd * g1[1], y6 = bflo(w.w) * rstd * g1[2], y7 = bfhi(w.w) * rstd * g1[3];
      if (t0 >= 0) { const f32x2* cs = rope + (d0 < 4 ? prow : pcol) * 32 + (d0 & 3) * 8 + hi * 4;
        const f32x2 c0 = cs[0], c1 = cs[1], c2 = cs[2], c3 = cs[3]; float x1, x2;
        x1 = y0; x2 = y1; y0 = x1 * c0.x - x2 * c0.y; y1 = x1 * c0.y + x2 * c0.x;
        x1 = y2; x2 = y3; y2 = x1 * c1.x - x2 * c1.y; y3 = x1 * c1.y + x2 * c1.x;
        x1 = y4; x2 = y5; y4 = x1 * c2.x - x2 * c2.y; y5 = x1 * c2.y + x2 * c2.x;
        x1 = y6; x2 = y7; y6 = x1 * c3.x - x2 * c3.y; y7 = x1 * c3.y + x2 * c3.x; }
      u32x4 o_; o_.x = cvtpk(y0, y1); o_.y = cvtpk(y2, y3); o_.z = cvtpk(y4, y5); o_.w = cvtpk(y6, y7); qr[d0] = __builtin_bit_cast(bf16x8, o_); }
  }
  const int sr = tid >> 4, sc = (tid & 15) * 8, vst0 = v_st(sr, sc), vst1 = v_st(32 + sr, sc);
  const int vb0 = (int)(unsigned)(uintptr_t)V_lds + v_rd_base(lane);
  struct { bf16x8 vs0, vs1, ks0, ks1; } sr_[1];
  const unsigned vo0 = (unsigned)((sr * LDK + sc) * 2);
#define SLOAD(i, k0) do { const char* vt_ = (const char*)Vh + (size_t)(k0) * (LDK * 2); const char* kt_ = (const char*)Kh + (size_t)(k0) * (LDK * 2); \
    sr_[i].vs0 = *(const bf16x8*)(vt_ + vo0); sr_[i].vs1 = *(const bf16x8*)(vt_ + 32 * LDK * 2 + vo0); \
    sr_[i].ks0 = *(const bf16x8*)(kt_ + vo0); sr_[i].ks1 = *(const bf16x8*)(kt_ + 32 * LDK * 2 + vo0); } while (0)
#define SWRITE(b, i) do { *(LAS bf16x8*)(V_lds + (b) * SHM_V + vst0) = sr_[i].vs0;          \
    *(LAS bf16x8*)(V_lds + (b) * SHM_V + vst1) = sr_[i].vs1; int kc = sc * 2;               \
    *(LAS bf16x8*)(K_lds + (b) * SHM_K + KSWZ(sr, kc)) = sr_[i].ks0;                       \
    *(LAS bf16x8*)(K_lds + (b) * SHM_K + KSWZ(32 + sr, kc)) = sr_[i].ks1; } while (0)
#define SWAIT() asm volatile("s_waitcnt vmcnt(0)" ::: "memory")
#define RESC(a) do { if (__any((a) < 1.f)) { if (hi == 0) al_l[r32] = (a); asm volatile("s_waitcnt lgkmcnt(0)" ::: "memory"); \
    _Pragma("unroll") for (int d = 0; d < 4; ++d) _Pragma("unroll") for (int r = 0; r < 16; ++r) o[d][r] *= al_l[crow(r, hi)]; } } while (0)
  f32x16 pA0, pA1, pB0, pB1; float alA, alB; bf16x8 pa0, pa1, pa2, pa3; const int NT = seq / KVBLK;
  SLOAD(0, 0); asm volatile("s_waitcnt vmcnt(0)" ::: "memory"); SWRITE(0, 0); __syncthreads();
  qkt(pA0, pA1, K_lds, qr, negm, r32, hi); partialSM(pA0, pA1, m_reg, negm, alA);
  SLOAD(0, KVBLK);
  SWAIT(); SWRITE(1, 0); __syncthreads();
  for (int j = 1; j + 1 < NT; j += 2) {
    SBAR(); qkt(pB0, pB1, K_lds + SHM_K, qr, negm, r32, hi);
    finishSM(pA0, pA1, alA, l_reg, pa0, pa1, pa2, pa3); SBAR();
    SLOAD(0, (j + 1) * KVBLK); SBAR();
    pv_d0(o, vb0, pa0, pa1, pa2, pa3); partialSM(pB0, pB1, m_reg, negm, alB);
    __syncthreads(); SWAIT(); SWRITE(0, 0);
    RESC(alB); __syncthreads();
    SBAR(); qkt(pA0, pA1, K_lds, qr, negm, r32, hi);
    finishSM(pB0, pB1, alB, l_reg, pa0, pa1, pa2, pa3); SBAR();
    SLOAD(0, (j + 2) * KVBLK); SBAR();
    pv_d0(o, vb0 + (int)SHM_V, pa0, pa1, pa2, pa3); partialSM(pA0, pA1, m_reg, negm, alA);
    __syncthreads(); SWAIT(); SWRITE(1, 0);
    RESC(alA); __syncthreads();
  }
  SBAR(); qkt(pB0, pB1, K_lds + SHM_K, qr, negm, r32, hi);
  finishSM(pA0, pA1, alA, l_reg, pa0, pa1, pa2, pa3); SBAR();
  pv_d0(o, vb0, pa0, pa1, pa2, pa3); partialSM(pB0, pB1, m_reg, negm, alB);
  __syncthreads(); RESC(alB);
  finishSM(pB0, pB1, alB, l_reg, pa0, pa1, pa2, pa3); SBAR();
  pv_d0(o, vb0 + (int)SHM_V, pa0, pa1, pa2, pa3);
  if (hi == 0) li_l[r32] = l_reg; asm volatile("s_waitcnt lgkmcnt(0)" ::: "memory");
  float rli[16];
#pragma unroll
  for (int r = 0; r < 16; ++r) rli[r] = __builtin_amdgcn_rcpf(li_l[crow(r, hi)]);
  bf16_t* Ow = Ob + (long)(wid * QBLK) * LDO;
#pragma unroll
  for (int r = 0; r < 16; ++r) { int orow = crow(r, hi);
#pragma unroll
    for (int d0 = 0; d0 < 4; ++d0) Ow[(long)orow * LDO + d0 * 32 + r32] = f2bf(o[d0][r] * rli[r]); }
#undef SLOAD
#undef SWRITE
#undef SWAIT
#undef RESC
}
}

#define XB_TMO      128
#define XB_XCNT(j)  (256  + 64 * (j))
#define XB_XSUB(j)  (1280 + 64 * (j))
#define XB_XGEN(j)  (2304 + 64 * (j))
#define XB_TOP      3328
#define XB_TOPGEN   3392
#define XCD_BAR_WORDS 3456
#define XB_SPIN_CAP (1u << 18)

__device__ __forceinline__ unsigned xb_ld(unsigned* p)              { return __hip_atomic_load(p, __ATOMIC_RELAXED, __HIP_MEMORY_SCOPE_AGENT); }
__device__ __forceinline__ unsigned xb_add(unsigned* p, unsigned v) { return __hip_atomic_fetch_add(p, v, __ATOMIC_RELAXED, __HIP_MEMORY_SCOPE_AGENT); }
__device__ __forceinline__ unsigned xb_xcc_id() { return (unsigned)__builtin_amdgcn_s_getreg((3 << 11) | 20) & 0xFu; }
#define XB_SPIN(cond, bar) do { unsigned _sp = 0; while (cond) { __builtin_amdgcn_s_sleep(1); \
    if ((++_sp & 255u) == 0u) { if (xb_ld(&(bar)[XB_TMO])) break; if (_sp > XB_SPIN_CAP) { atomicAdd(&(bar)[XB_TMO], 1u); break; } } } } while (0)

struct XcdBarrier { unsigned* bar; unsigned x; volatile LAS unsigned* st; };

__device__ __forceinline__ XcdBarrier xcd_barrier_post(unsigned* bar, volatile LAS unsigned* st) {
    XcdBarrier b; b.bar = bar; b.x = xb_xcc_id(); b.st = st;
    if (threadIdx.x == 0) (void)xb_add(&bar[XB_XCNT(b.x)], 1u);
    return b;
}
__device__ __forceinline__ void xcd_barrier_complete(unsigned* bar, unsigned x, unsigned& nloc, unsigned& nx) {
    const unsigned G = gridDim.x * gridDim.y * gridDim.z;
    unsigned sum, cnt, mine, sp = 0u;
    for (;;) {
        sum = 0u; cnt = 0u; mine = 0u;
#pragma unroll
        for (unsigned j = 0; j < 16; ++j) { const unsigned c = xb_ld(&bar[XB_XCNT(j)]); sum += c; cnt += (c > 0u) ? 1u : 0u; mine = (j == x) ? c : mine; }
        if (sum == G) break;
        __builtin_amdgcn_s_sleep(1);
        if ((++sp & 255u) == 0u) { if (xb_ld(&bar[XB_TMO])) break; if (sp > XB_SPIN_CAP) { atomicAdd(&bar[XB_TMO], 1u); break; } }
    }
    nloc = mine > 0u ? mine : 1u; nx = cnt > 0u ? cnt : 1u;
}
__device__ __forceinline__ void xcd_barrier(const XcdBarrier& b) {
    asm volatile("s_waitcnt vmcnt(0)" ::: "memory");
    __syncthreads();
    if (threadIdx.x == 0) {
        unsigned* bar = b.bar;
        __builtin_amdgcn_s_waitcnt(0);
        unsigned nloc = b.st[0], nx = b.st[1];
        if (nloc == 0u) { xcd_barrier_complete(bar, b.x, nloc, nx); b.st[0] = nloc; b.st[1] = nx; }
        const unsigned old = xb_add(&bar[XB_XSUB(b.x)], 1u);
        const unsigned gen = old / nloc;
        if (old + 1u == (gen + 1u) * nloc) {
            __builtin_amdgcn_fence(__ATOMIC_RELEASE, "agent");
            asm volatile("s_waitcnt vmcnt(0)" ::: "memory");
            const unsigned og = xb_add(&bar[XB_TOP], 1u);
            const unsigned tg = og / nx;
            if (og + 1u == (tg + 1u) * nx) xb_add(&bar[XB_TOPGEN], 1u);
            else XB_SPIN(xb_ld(&bar[XB_TOPGEN]) == tg, bar);
            __builtin_amdgcn_fence(__ATOMIC_ACQUIRE, "agent");
            xb_add(&bar[XB_XGEN(b.x)], 1u);
            asm volatile("s_waitcnt vmcnt(0)" ::: "memory");
        } else {
            XB_SPIN(xb_ld(&bar[XB_XGEN(b.x)]) == gen, bar);
            __builtin_amdgcn_fence(__ATOMIC_ACQUIRE, "agent");
            asm volatile("s_waitcnt vmcnt(0)" ::: "memory");
        }
    }
    __syncthreads();
}

struct Args { const float* in[25]; float* out; unsigned char* ws; int ph_lo, ph_hi; };
enum { I_XP = 0, I_XS, I_CK, I_CV, I_C, I_CCTX, I_WMOD, I_BMOD, I_NMPRE, I_NMPOST, I_NFPRE, I_NFPOST, I_AWIN, I_ANV, I_AWS, I_ABS, I_AWOUT,
       I_BWQKV, I_BQN, I_BKN, I_BWO, I_CWP, I_CSC, I_FWGU, I_FWDN };
constexpr int NPHASE = 35;

__device__ __forceinline__ void tr_item(const float* W, int K, int N, bf16_t* WT, int mode, LAS float* scr, int item, int lane) {
    const int nblk = N / 32, kb = item / nblk, nb = item % nblk, k0 = 64 * kb, n0 = 32 * nb;
    int d0 = n0;
    if (mode == 1) d0 = n0 < FFH ? (n0 / 128) * 256 + (n0 % 128) : ((n0 - FFH) / 128) * 256 + 128 + ((n0 - FFH) % 128);
    float tv_[32];
#pragma unroll
    for (int i = 0; i < 32; ++i) { const int kk = 2 * i + (lane >> 5); tv_[i] = __builtin_nontemporal_load(W + (size_t)(k0 + kk) * N + n0 + (lane & 31)); }
#pragma unroll
    for (int i = 0; i < 32; ++i) { const int kk = 2 * i + (lane >> 5); scr[kk * 33 + (lane & 31)] = tv_[i]; }
    asm volatile("s_waitcnt lgkmcnt(0)" ::: "memory");
    const int c = lane & 7;
#pragma unroll
    for (int j = 0; j < 4; ++j) { const int n = (lane >> 3) + 8 * j; const LAS float* s = scr + (8 * c) * 33 + n;
        u32x4 o; o.x = cvt_pk_bf16(s[0 * 33], s[1 * 33]); o.y = cvt_pk_bf16(s[2 * 33], s[3 * 33]); o.z = cvt_pk_bf16(s[4 * 33], s[5 * 33]); o.w = cvt_pk_bf16(s[6 * 33], s[7 * 33]);
        __builtin_nontemporal_store(o, (u32x4*)(WT + (size_t)(d0 + n) * K + k0 + 8 * c)); }
    asm volatile("s_waitcnt lgkmcnt(0)" ::: "memory");
}
__device__ __forceinline__ void tr_matrix(const float* W, int K, int N, bf16_t* WT, int mode, LAS float* scr, int gw, int ngw, int lane) {
    const int nitems = (K / 64) * (N / 32);
    for (int it = gw; it < nitems; it += ngw) tr_item(W, K, N, WT, mode, scr, it, lane);
}

__global__ void __launch_bounds__(NTHR, 2) fwd(Args args) {
    extern __shared__ __attribute__((aligned(16))) unsigned char lds_raw[];
    LAS unsigned char* lds = (LAS unsigned char*)lds_raw;
    typedef const __attribute__((address_space(4))) unsigned char* kptr_t;
    const int G = gridDim.x, bid = blockIdx.x;
    const int vcu = __builtin_amdgcn_readfirstlane((G % 8 == 0) ? (bid % 8) * (G / 8) + bid / 8 : bid);
    const int lo = args.ph_lo, hi = args.ph_hi;
    {
        const int tid0 = threadIdx.x;
        for (int u = tid0; u < (LDS_BYTES - RING_BYTES) / 4; u += NTHR) ((LAS unsigned*)(lds + RING_BYTES))[u] = 0u;
        __syncthreads();
    }
    XcdBarrier bar; bar.bar = (unsigned*)(args.ws + WS_CTL) + CW_BAR; bar.x = 0; bar.st = (volatile LAS unsigned*)(lds + MISC_OFF + 32);
    if (hi - lo > 1) bar = xcd_barrier_post((unsigned*)(args.ws + WS_CTL) + CW_BAR, (volatile LAS unsigned*)(lds + MISC_OFF + 32));

#define KARG_IN(i) (*(const float* const __attribute__((address_space(4)))*)(kp + 8 * (i)))
#define PH_BEGIN(id) if (lo <= (id) && (id) < hi) { \
    kptr_t kp = (kptr_t)__builtin_amdgcn_kernarg_segment_ptr(); asm volatile("" : "+s"(kp)); \
    unsigned char* ws = *(unsigned char* const __attribute__((address_space(4)))*)(kp + 8 * 26); float* OUT = *(float* const __attribute__((address_space(4)))*)(kp + 8 * 25); \
    int tid = threadIdx.x; asm volatile("" : "+v"(tid)); const int lane = tid & 63, wave = __builtin_amdgcn_readfirstlane(tid >> 6); (void)lane; (void)wave; (void)OUT; (void)ws;
#define PH_END(id) if ((id) + 1 < hi) xcd_barrier(bar); }
#define MODP ((float*)(ws + WS_MODP))
#define MOD ((float*)(ws + WS_MOD))
#define ROPE ((f32x2*)(ws + WS_ROPE))
#define VSS ((float*)(ws + WS_VSS))
#define WGU ((bf16_t*)(ws + WS_WGU))
#define WDN ((bf16_t*)(ws + WS_WDN))
#define WIN ((bf16_t*)(ws + WS_WIN))
#define WOUT ((bf16_t*)(ws + WS_WOUT))
#define WQKV ((bf16_t*)(ws + WS_WQKV))
#define WO ((bf16_t*)(ws + WS_WO))
#define WPOOL ((bf16_t*)(ws + WS_WPOOL))
#define HB ((bf16_t*)(ws + WS_H))
#define MB ((bf16_t*)(ws + WS_MB))
#define BIG ((bf16_t*)(ws + WS_BIG))
#define UB BIG
#define VBUF ((bf16_t*)(ws + WS_BIG + BIG_V))
#define QB BIG
#define KRAW ((bf16_t*)(ws + WS_BIG + BIG_KR))
#define VRAW ((bf16_t*)(ws + WS_BIG + BIG_VR))
#define KB ((bf16_t*)(ws + WS_KB))
#define VB ((bf16_t*)(ws + WS_VB))
#define XB ((bf16_t*)(ws + WS_XB))

    PH_BEGIN(0)
    {
        const int gw = vcu * NWAVES + wave, ngw = G * NWAVES;
        LAS float* scr = (LAS float*)(lds + wave * 16384);
        for (int l = 0; l < 4; ++l) {
            tr_matrix(KARG_IN(I_FWGU) + (size_t)l * DM * 2 * FFH, DM, 2 * FFH, WGU + (size_t)l * 2 * FFH * DM, 1, scr, gw, ngw, lane);
            tr_matrix(KARG_IN(I_FWDN) + (size_t)l * FFH * DM, FFH, DM, WDN + (size_t)l * DM * FFH, 0, scr, gw, ngw, lane);
        }
        for (int l = 0; l < 2; ++l) {
            tr_matrix(KARG_IN(I_AWIN) + (size_t)l * DM * 2 * DM, DM, 2 * DM, WIN + (size_t)l * 2 * DM * DM, 0, scr, gw, ngw, lane);
            tr_matrix(KARG_IN(I_AWOUT) + (size_t)l * DM * DM, DM, DM, WOUT + (size_t)l * DM * DM, 0, scr, gw, ngw, lane);
        }
        tr_matrix(KARG_IN(I_BWQKV), DM, 3072, WQKV, 0, scr, gw, ngw, lane);
        tr_matrix(KARG_IN(I_BWO), DM, DM, WO, 0, scr, gw, ngw, lane);
        for (int gq = 0; gq < 4; ++gq) tr_matrix(KARG_IN(I_CWP) + (size_t)gq * 512 * 512, 512, 512, WPOOL + (size_t)gq * 512 * 512, 0, scr, gw, ngw, lane);
        __syncthreads();
        LAS float* sl = (LAS float*)lds;
        for (int i = tid; i < NCOND * DM; i += NTHR) { const int b = i / DM, k = i % DM; const float c = b == 0 ? KARG_IN(I_CCTX)[k] : KARG_IN(I_C)[(b - 1) * DM + k]; sl[i] = c / (1.0f + expf(-c)); }
        __syncthreads();
        for (int it = vcu; it < 4 * 24 * 8; it += G) {
            const int l = it / 192, cb = (it % 192) / 8, ks = it % 8, col = cb * 512 + tid;
            float acc[NCOND];
#pragma unroll
            for (int b = 0; b < NCOND; ++b) acc[b] = 0.f;
            const float* wp = KARG_IN(I_WMOD) + ((size_t)l * DM + ks * 256) * MODW + col;
#pragma unroll 8
            for (int k4 = 0; k4 < 64; ++k4) {
                const float w0 = __builtin_nontemporal_load(wp + (size_t)(4 * k4 + 0) * MODW), w1 = __builtin_nontemporal_load(wp + (size_t)(4 * k4 + 1) * MODW), w2 = __builtin_nontemporal_load(wp + (size_t)(4 * k4 + 2) * MODW), w3 = __builtin_nontemporal_load(wp + (size_t)(4 * k4 + 3) * MODW);
#pragma unroll
                for (int b = 0; b < NCOND; ++b) { const f32x4 s4 = *(const LAS f32x4*)(sl + b * DM + ks * 256 + 4 * k4); acc[b] += (s4[0] * w0 + s4[1] * w1) + (s4[2] * w2 + s4[3] * w3); }
            }
#pragma unroll
            for (int b = 0; b < NCOND; ++b) MODP[((size_t)(l * 8 + ks) * NCOND + b) * MODW + col] = acc[b];
        }
        for (size_t i = (size_t)bid * NTHR + tid; i < (size_t)2 * LAT_B * PAST * 64; i += (size_t)G * NTHR) {
            const int which = (int)(i / ((size_t)LAT_B * PAST * 64)); const size_t j = i % ((size_t)LAT_B * PAST * 64);
            const int b = (int)(j / (PAST * 64)), s = (int)((j / 64) % PAST), c8 = (int)(j % 64) * 8;
            const float* src = KARG_IN(which ? I_CV : I_CK) + ((size_t)(b * PAST + s) * 512 + c8);
            const f32x4 a = __builtin_nontemporal_load((const f32x4*)src), bb = __builtin_nontemporal_load((const f32x4*)(src + 4));
            u32x4 w; w.x = cvt_pk_bf16(a[0], a[1]); w.y = cvt_pk_bf16(a[2], a[3]); w.z = cvt_pk_bf16(bb[0], bb[1]); w.w = cvt_pk_bf16(bb[2], bb[3]);
            *(u32x4*)((which ? VB : KB) + ((size_t)(NCTX + b * KV_T + LAT_T + s) * 512 + c8)) = w;
        }
        if (bid == 0) for (int i = tid; i < 64 * 32; i += NTHR) { const int pos = i / 32, j = i % 32; const float inv = powf(10000.0f, -(float)(2 * j) / 64.0f); const float ang = (float)pos * inv;
            ROPE[i] = (f32x2){cosf(ang), sinf(ang)}; }
        __syncthreads();
    }
    PH_END(0)

    PH_BEGIN(1)
    for (int i = bid * NTHR + tid; i < 4 * NCOND * MODW; i += G * NTHR) {
        const int l = i / (NCOND * MODW), b = (i / MODW) % NCOND, j = i % MODW;
        float s = KARG_IN(I_BMOD)[l * MODW + j];
#pragma unroll
        for (int ks = 0; ks < 8; ++ks) s += MODP[((size_t)(l * 8 + ks) * NCOND + b) * MODW + j];
        MOD[i] = s;
    }
    PH_END(1)

    for (int l = 0; l <= 4; ++l) {
        const int kind = l % 3, ia = l / 3, pbase = 2 + 8 * l;
        for (int half = 0; half < 2; ++half) {
            if (half == 1 && l == 4) break;
            const int pid = half == 0 ? (l == 4 ? 34 : pbase) : pbase + 5;
            if (half == 1) {
                if (kind == 0) {
                    PH_BEGIN(pbase + 1)
                    { pg8::Gemm g{HB, WIN + (size_t)ia * 2 * DM * DM, DM, DM, DM, 31}; pg8::StaticOrder S; S.init(MTOK, 2 * DM, G, bid);
                      pg8::EpiUV E{UB, VBUF, VSS}; pg8::gemm_phase<pg8::EpiUV, pg8::StaticOrder>(lds, g, S, E, tid); }
                    PH_END(pbase + 1)
                    PH_BEGIN(pbase + 2)
                    {
                        constexpr int NUH = (MTOK / 128) * 16, S_OFF = 32768, S_STRIDE = 264;
                        const int H = wave >> 2, ht = tid & 255, pr = wave & 3, r32 = lane & 31, hh = lane >> 5;
                        LAS unsigned char* Lh = lds + H * 66560;
                        LAS float* rsb = (LAS float*)(lds + 133120 + H * 1024);
                        LAS float* bgl = (LAS float*)(lds + 135168 + H * 1024);
                        const float* Ws = KARG_IN(I_AWS) + (size_t)ia * 8 * 128 * 128; const float* Bs = KARG_IN(I_ABS) + (size_t)ia * 8 * 128; const float* Gv = KARG_IN(I_ANV) + (size_t)ia * DM;
                        const int ustart = vcu * 2 + H, ustride = 2 * G, nmax = (NUH + ustride - 1) / ustride;
                        const int sr = ht >> 4, sc = (ht & 15) * 8;
#define GATE_BAR() do { asm volatile("s_waitcnt lgkmcnt(0)" ::: "memory"); __builtin_amdgcn_s_barrier(); asm volatile("" ::: "memory"); } while (0)
#define GATE_RS(UU, BUF) do { if (ht < 128) { const f32x4* vp4 = (const f32x4*)(VSS + (size_t)(((UU) >> 4) * 128 + ht) * 32); float sq = 0.f; \
                                _Pragma("unroll") for (int i = 0; i < 8; ++i) { const f32x4 t4 = vp4[i]; sq += (t4[0] + t4[1]) + (t4[2] + t4[3]); } \
                                rsb[(BUF) * 128 + ht] = 1.0f / sqrtf(sq * (1.0f / DM) + EPS); } } while (0)
#define GATE_SC8(V, R) ({ const u32x4 w_ = __builtin_bit_cast(u32x4, (V)); u32x4 o_; o_.x = cvt_pk_bf16(bflo(w_.x) * (R), bfhi(w_.x) * (R)); o_.y = cvt_pk_bf16(bflo(w_.y) * (R), bfhi(w_.y) * (R)); \
                                o_.z = cvt_pk_bf16(bflo(w_.z) * (R), bfhi(w_.z) * (R)); o_.w = cvt_pk_bf16(bflo(w_.w) * (R), bfhi(w_.w) * (R)); __builtin_bit_cast(bf16x8, o_); })
                        int cur_key = -1; bool have_prev = false; size_t pgo = 0;
                        if (ustart < NUH) GATE_RS(ustart, 0);
                        __syncthreads();
                        if (H == 1) GATE_BAR();
                        for (int it = 0; it < nmax; ++it) {
                            const int u = ustart + it * ustride; const bool valid = u < NUH;
                            const int n = u >> 4, gq = (u >> 1) & 7, hf = u & 1, row0 = n * 128;
                            if (valid && (u & 15) != cur_key) {
                                cur_key = u & 15;
                                if (ht < 128) bgl[ht] = Bs[gq * 128 + ht]; else bgl[ht] = Gv[gq * 256 + hf * 128 + (ht - 128)];
                            }
                            { const int un = u + ustride; if (un < NUH) GATE_RS(un, (it + 1) & 1); }
                            if (have_prev) {
#pragma unroll
                                for (int i_ = 0; i_ < 8; ++i_) { const int ci = ht + i_ * 256, pp_ = ci >> 4, ch = ci & 15;
                                    const LAS u32x2* sp = (const LAS u32x2*)(Lh + S_OFF + pp_ * S_STRIDE + ch * 16); const u32x2 s0 = sp[0], s1 = sp[1];
                                    const size_t go = pgo + (size_t)pp_ * DM + ch * 8; const u32x4 uw = __builtin_nontemporal_load((const u32x4*)(UB + go)); u32x4 ow;
                                    ow.x = cvt_pk_bf16(bflo(uw.x) * bflo(s0.x), bfhi(uw.x) * bfhi(s0.x)); ow.y = cvt_pk_bf16(bflo(uw.y) * bflo(s0.y), bfhi(uw.y) * bfhi(s0.y));
                                    ow.z = cvt_pk_bf16(bflo(uw.z) * bflo(s1.x), bfhi(uw.z) * bfhi(s1.x)); ow.w = cvt_pk_bf16(bflo(uw.w) * bflo(s1.y), bfhi(uw.w) * bfhi(s1.y));
                                    *(u32x4*)(HB + go) = ow; }
                                have_prev = false;
                            }
                            if (valid) {
                                const LAS float* rsc = rsb + (it & 1) * 128;
                                const bf16_t* src = VBUF + (size_t)(row0 + sr) * DM + gq * 256 + hf * 128 + sc;
#pragma unroll
                                for (int kt = 0; kt < 2; ++kt)
#pragma unroll
                                    for (int j = 0; j < 4; ++j) { const int q = kt * 64 + sr + 16 * j;
                                        const bf16x8 v = __builtin_nontemporal_load((const bf16x8*)(src + (size_t)(kt * 64 + 16 * j) * DM));
                                        *(LAS bf16x8*)(Lh + kt * 16384 + att::v_st(sr + 16 * j, sc)) = GATE_SC8(v, rsc[q]); }
                            }
                            GATE_BAR();
                            if (valid) {
                                f32x16 o[4] = {};
#pragma unroll
                                for (int kt = 0; kt < 2; ++kt) {
                                    bf16x8 paW[4]; const float* wrow = Ws + ((size_t)gq * 128 + 32 * pr + r32) * 128 + kt * 64 + 8 * hh;
#pragma unroll
                                    for (int s2 = 0; s2 < 4; ++s2) { const f32x4 wa = *(const f32x4*)(wrow + 16 * s2), wb = *(const f32x4*)(wrow + 16 * s2 + 4);
                                        u32x4 w; w.x = cvt_pk_bf16(wa[0], wa[1]); w.y = cvt_pk_bf16(wa[2], wa[3]); w.z = cvt_pk_bf16(wb[0], wb[1]); w.w = cvt_pk_bf16(wb[2], wb[3]);
                                        paW[s2] = __builtin_bit_cast(bf16x8, w); }
                                    const int vb = (int)(unsigned)(uintptr_t)(Lh + kt * 16384) + att::v_rd_base(lane);
                                    att::pv_d0(o, vb, paW[0], paW[1], paW[2], paW[3]);
                                }
                                float gvr[4];
#pragma unroll
                                for (int d0 = 0; d0 < 4; ++d0) gvr[d0] = bgl[128 + d0 * 32 + r32];
#pragma unroll
                                for (int r = 0; r < 16; ++r) { const int pp = 32 * pr + att::crow(r, hh); const float bs = bgl[pp];
#pragma unroll
                                    for (int d0 = 0; d0 < 4; ++d0) *(LAS unsigned short*)(Lh + S_OFF + pp * S_STRIDE + (d0 * 32 + r32) * 2) = f2bf(o[d0][r] * gvr[d0] + bs); }
                                have_prev = true; pgo = (size_t)row0 * DM + gq * 256 + hf * 128;
                            }
                            GATE_BAR();
                        }
                        if (have_prev) {
#pragma unroll
                            for (int i_ = 0; i_ < 8; ++i_) { const int ci = ht + i_ * 256, pp_ = ci >> 4, ch = ci & 15;
                                const LAS u32x2* sp = (const LAS u32x2*)(Lh + S_OFF + pp_ * S_STRIDE + ch * 16); const u32x2 s0 = sp[0], s1 = sp[1];
                                const size_t go = pgo + (size_t)pp_ * DM + ch * 8; const u32x4 uw = __builtin_nontemporal_load((const u32x4*)(UB + go)); u32x4 ow;
                                ow.x = cvt_pk_bf16(bflo(uw.x) * bflo(s0.x), bfhi(uw.x) * bfhi(s0.x)); ow.y = cvt_pk_bf16(bflo(uw.y) * bflo(s0.y), bfhi(uw.y) * bfhi(s0.y));
                                ow.z = cvt_pk_bf16(bflo(uw.z) * bflo(s1.x), bfhi(uw.z) * bfhi(s1.x)); ow.w = cvt_pk_bf16(bflo(uw.w) * bflo(s1.y), bfhi(uw.w) * bfhi(s1.y));
                                *(u32x4*)(HB + go) = ow; }
                        }
                        if (H == 0) GATE_BAR();
                        __syncthreads();
#undef GATE_BAR
#undef GATE_RS
#undef GATE_SC8
                    }
                    PH_END(pbase + 2)
                } else if (kind == 1) {
                    PH_BEGIN(pbase + 1)
                    { pg8::Gemm g{HB, WQKV, DM, DM, DM, 31}; pg8::StaticOrder S; S.init(MTOK, 3072, G, bid);
                      pg8::EpiQKV E{QB, KRAW, VB, OUT + OUT_SV}; pg8::gemm_phase<pg8::EpiQKV, pg8::StaticOrder>(lds, g, S, E, tid); }
                    PH_END(pbase + 1)
                    PH_BEGIN(pbase + 2)
                    {
                        const float* kn = KARG_IN(I_BKN);
                        for (int u = vcu; u < MTOK / 32; u += G) {
                            for (int rr = 0; rr < 4; ++rr) {
                                const int r = u * 32 + wave * 4 + rr; const bool lat = r >= NCTX;
                                int kvrow = r, prow = 0, pcol = 0;
                                if (lat) { const int b = (r - NCTX) >> 12, t = (r - NCTX) & 4095; kvrow = NCTX + b * KV_T + t; prow = t >> 6; pcol = t & 63; }
                                {
                                    const u32x4 w = __builtin_nontemporal_load((const u32x4*)(KRAW + (size_t)r * 512 + lane * 8)); float x[8];
                                    x[0] = bflo(w.x); x[1] = bfhi(w.x); x[2] = bflo(w.y); x[3] = bfhi(w.y); x[4] = bflo(w.z); x[5] = bfhi(w.z); x[6] = bflo(w.w); x[7] = bfhi(w.w);
                                    float ss = 0.f;
#pragma unroll
                                    for (int i = 0; i < 8; ++i) ss += x[i] * x[i];
                                    ss = row16_sum(ss);
                                    const float rstd = 1.0f / sqrtf(ss * (1.0f / 128.0f) + EPS); const int l16 = lane & 15;
#pragma unroll
                                    for (int i = 0; i < 8; ++i) x[i] = x[i] * rstd * kn[l16 * 8 + i];
                                    if (lat) { const f32x2* cs = ROPE + (l16 < 8 ? prow : pcol) * 32 + ((l16 * 4) & 31);
#pragma unroll
                                        for (int ii = 0; ii < 4; ++ii) { const f32x2 c = cs[ii]; const float x1 = x[2 * ii], x2 = x[2 * ii + 1]; x[2 * ii] = x1 * c.x - x2 * c.y; x[2 * ii + 1] = x1 * c.y + x2 * c.x; } }
                                    u32x4 o; o.x = cvt_pk_bf16(x[0], x[1]); o.y = cvt_pk_bf16(x[2], x[3]); o.z = cvt_pk_bf16(x[4], x[5]); o.w = cvt_pk_bf16(x[6], x[7]);
                                    *(u32x4*)(KB + (size_t)kvrow * 512 + lane * 8) = o;
                                    if (!lat) { float* sk = OUT + OUT_SK + (size_t)r * 512 + lane * 8; *(f32x4*)sk = (f32x4){x[0], x[1], x[2], x[3]}; *(f32x4*)(sk + 4) = (f32x4){x[4], x[5], x[6], x[7]}; }
                                }
                            }
                        }
                    }
                    PH_END(pbase + 2)
                    PH_BEGIN(pbase + 3)
                    {
                        char* ldsg = (char*)lds_raw;
                        for (int s = vcu; s < 2048 + 512; s += G) {
                            int qrow, kvrow0, h, kvh, seq, t0q;
                            if (s < 2048) {
                                int pidx, uip;
                                if (G == 256) { const int i = s >> 8, v = s & 255, x = v >> 5, j = v & 31; pidx = x * 4 + (i >> 1); uip = (i & 1) * 32 + j; } else { pidx = s >> 6; uip = s & 63; }
                                const int b = pidx >> 2, qb = uip & 15; kvh = pidx & 3; h = kvh * 4 + (uip >> 4);
                                qrow = NCTX + b * LAT_T + qb * 256; kvrow0 = NCTX + b * KV_T; seq = KV_T; t0q = qb * 256;
                            } else {
                                const int id = s - 2048, b = id >> 4; h = id & 15; kvh = h >> 2; qrow = b * 256; kvrow0 = qrow; seq = 256; t0q = -1;
                            }
                            const size_t qoff = (size_t)__builtin_amdgcn_readfirstlane(qrow) * DM + (size_t)__builtin_amdgcn_readfirstlane(h * 128);
                            const size_t koff = (size_t)__builtin_amdgcn_readfirstlane(kvrow0) * 512 + (size_t)__builtin_amdgcn_readfirstlane(kvh * 128);
                            seq = __builtin_amdgcn_readfirstlane(seq);
                            const bf16_t* qp = QB + qoff; bf16_t* op = HB + qoff; const bf16_t* kkp = KB + koff; const bf16_t* vp = VB + koff;
                            att::attn_dense_body(qp, kkp, vp, op, seq, (LAS char*)lds, tid, KARG_IN(I_BQN), ROPE, __builtin_amdgcn_readfirstlane(t0q));
                            __syncthreads();
                        }
                    }
                    PH_END(pbase + 3)
                } else {
                    PH_BEGIN(pbase + 1)
                    {
                        for (int u = vcu; u < MTOK / 32; u += G) {
                            const int r0 = u * 32 + wave * 4;
                            int base, T; if (r0 < NCTX) { base = r0 & ~255; T = 256; } else { base = NCTX + ((r0 - NCTX) & ~4095); T = LAT_T; }
                            const int t0 = r0 - base;
#define POOL_GRP(GI) { constexpr int W = 2 << (GI), HW = W / 2, NR = 3 + W; const int col = (GI) * 512 + lane * 8; u32x4 v[NR]; \
                                _Pragma("unroll") for (int i = 0; i < NR; ++i) { const int t = t0 - HW + i; v[i] = (t >= 0 && t < T) ? *(const u32x4*)(HB + (size_t)(base + t) * DM + col) : (u32x4){0u, 0u, 0u, 0u}; } \
                                _Pragma("unroll") for (int rr = 0; rr < 4; ++rr) { const int t = t0 + rr; const int lo_ = t - HW > 0 ? t - HW : 0, hi_ = t + HW < T ? t + HW : T; const float ic = 1.0f / (float)(hi_ - lo_); \
                                    float s[8] = {0.f, 0.f, 0.f, 0.f, 0.f, 0.f, 0.f, 0.f}; \
                                    _Pragma("unroll") for (int k = 0; k < W; ++k) { const u32x4 w = v[rr + k]; s[0] += bflo(w.x); s[1] += bfhi(w.x); s[2] += bflo(w.y); s[3] += bfhi(w.y); s[4] += bflo(w.z); s[5] += bfhi(w.z); s[6] += bflo(w.w); s[7] += bfhi(w.w); } \
                                    const u32x4 c = v[rr + HW]; u32x4 o; \
                                    o.x = cvt_pk_bf16(s[0] * ic - bflo(c.x), s[1] * ic - bfhi(c.x)); o.y = cvt_pk_bf16(s[2] * ic - bflo(c.y), s[3] * ic - bfhi(c.y)); \
                                    o.z = cvt_pk_bf16(s[4] * ic - bflo(c.z), s[5] * ic - bfhi(c.z)); o.w = cvt_pk_bf16(s[6] * ic - bflo(c.w), s[7] * ic - bfhi(c.w)); \
                                    *(u32x4*)(BIG + (size_t)(r0 + rr) * DM + col) = o; } }
                            POOL_GRP(0) POOL_GRP(1) POOL_GRP(2) POOL_GRP(3)
#undef POOL_GRP
                        }
                    }
                    PH_END(pbase + 1)
                }
                PH_BEGIN(pbase + 4)
                {
                    pg8::Gemm g; pg8::EpiM E{MB, DM, nullptr};
                    if (kind == 0) g = pg8::Gemm{HB, WOUT + (size_t)ia * DM * DM, DM, DM, DM, 31};
                    else if (kind == 1) g = pg8::Gemm{HB, WO, DM, DM, DM, 31};
                    else { g = pg8::Gemm{BIG, WPOOL, DM, 512, 512, 1}; E.cscale = KARG_IN(I_CSC); }
                    pg8::StaticOrder S; S.init(MTOK, DM, G, bid);
                    pg8::gemm_phase<pg8::EpiM, pg8::StaticOrder>(lds, g, S, E, tid);
                }
                PH_END(pbase + 4)
            }
            PH_BEGIN(pid)
            {
                const bool has_post = !(half == 0 && l == 0), has_pre = !(half == 0 && l == 4);
                const int lp = half == 0 ? l - 1 : l;
                const float* gate = MOD + (size_t)(lp < 0 ? 0 : lp) * NCOND * MODW + (half == 0 ? 5 : 2) * DM;
                const float* gpost = KARG_IN(half == 0 ? I_NFPOST : I_NMPOST) + (size_t)(lp < 0 ? 0 : lp) * DM;
                const int lq = l > 3 ? 3 : l;
                const float* shiftp = MOD + (size_t)lq * NCOND * MODW + (half == 0 ? 0 : 3) * DM;
                const float* scalep = MOD + (size_t)lq * NCOND * MODW + (half == 0 ? 1 : 4) * DM;
                const float* gpre = KARG_IN(half == 0 ? I_NMPRE : I_NFPRE) + (size_t)lq * DM;
                const bool x_from_in = (l == 0);
                LAS float* vec = (LAS float*)lds;
                int cur_c = -1;
                for (int u = vcu; u < MTOK / 32; u += G) {
                    const int rb = u * 32; const int c = rb < NCTX ? 0 : 1 + ((rb - NCTX) >> 12);
                    if (c != cur_c) {
                        __syncthreads();
                        { const int cc = 4 * tid, jv = cc >> 9, wi = cc & 511, ln = wi >> 3, hf = (wi & 7) >> 2, li = ((jv * 2 + hf) * 64 + ln) * 4;
                          f32x4 gav = {0.f, 0.f, 0.f, 0.f}, sbv = {0.f, 0.f, 0.f, 0.f}, shv = {0.f, 0.f, 0.f, 0.f};
                          if (has_post) gav = *(const f32x4*)(gate + (size_t)c * MODW + cc) * *(const f32x4*)(gpost + cc);
                          if (has_pre) { sbv = *(const f32x4*)(gpre + cc) * (*(const f32x4*)(scalep + (size_t)c * MODW + cc) + 1.0f); shv = *(const f32x4*)(shiftp + (size_t)c * MODW + cc); }
                          *(LAS f32x4*)(vec + li) = gav; *(LAS f32x4*)(vec + 2048 + li) = sbv; *(LAS f32x4*)(vec + 4096 + li) = shv; }
                        cur_c = c;
                        __syncthreads();
                    }
#define NR_UNPK(W, LO, HI) do { LO = (f32x4){bflo((W).x), bfhi((W).x), bflo((W).y), bfhi((W).y)}; HI = (f32x4){bflo((W).z), bfhi((W).z), bflo((W).w), bfhi((W).w)}; } while (0)
#define NR_ROW(X, MW, R) do { \
                        if (has_post) { float ss = 0.f; f32x4 mv[8]; \
                            _Pragma("unroll") for (int j = 0; j < 4; ++j) { NR_UNPK(MW[j], mv[2 * j], mv[2 * j + 1]); } \
                            _Pragma("unroll") for (int k = 0; k < 8; ++k) ss += (mv[k][0] * mv[k][0] + mv[k][1] * mv[k][1]) + (mv[k][2] * mv[k][2] + mv[k][3] * mv[k][3]); \
                            ss = wave_sum(ss); const float rstd = 1.0f / sqrtf(ss * (1.0f / DM) + EPS); \
                            _Pragma("unroll") for (int k = 0; k < 8; ++k) { const f32x4 gav = *(const LAS f32x4*)(vec + (k * 64 + lane) * 4); X[k] = X[k] + gav * (mv[k] * rstd); } \
                            if (has_pre) { _Pragma("unroll") for (int j = 0; j < 4; ++j) { u32x4 xw_; xw_.x = cvt_pk_bf16(X[2 * j][0], X[2 * j][1]); xw_.y = cvt_pk_bf16(X[2 * j][2], X[2 * j][3]); xw_.z = cvt_pk_bf16(X[2 * j + 1][0], X[2 * j + 1][1]); xw_.w = cvt_pk_bf16(X[2 * j + 1][2], X[2 * j + 1][3]); \
                                    __builtin_nontemporal_store(xw_, (u32x4*)(XB + (size_t)(R) * DM + 512 * j + 8 * lane)); } } \
                            else { _Pragma("unroll") for (int k = 0; k < 8; ++k) __builtin_nontemporal_store(X[k], (f32x4*)(OUT + (size_t)(R) * DM + 512 * (k >> 1) + 8 * lane + 4 * (k & 1))); } } \
                        if (has_pre) { float ss = 0.f; \
                            _Pragma("unroll") for (int k = 0; k < 8; ++k) ss += (X[k][0] * X[k][0] + X[k][1] * X[k][1]) + (X[k][2] * X[k][2] + X[k][3] * X[k][3]); \
                            ss = wave_sum(ss); const float rstd = 1.0f / sqrtf(ss * (1.0f / DM) + EPS); \
                            _Pragma("unroll") for (int j = 0; j < 4; ++j) { \
                                const f32x4 sb0 = *(const LAS f32x4*)(vec + 2048 + ((2 * j) * 64 + lane) * 4), sb1 = *(const LAS f32x4*)(vec + 2048 + ((2 * j + 1) * 64 + lane) * 4); \
                                const f32x4 sh0 = *(const LAS f32x4*)(vec + 4096 + ((2 * j) * 64 + lane) * 4), sh1 = *(const LAS f32x4*)(vec + 4096 + ((2 * j + 1) * 64 + lane) * 4); \
                                const f32x4 h0 = X[2 * j] * rstd * sb0 + sh0, h1 = X[2 * j + 1] * rstd * sb1 + sh1; u32x4 w_; \
                                w_.x = cvt_pk_bf16(h0[0], h0[1]); w_.y = cvt_pk_bf16(h0[2], h0[3]); w_.z = cvt_pk_bf16(h1[0], h1[1]); w_.w = cvt_pk_bf16(h1[2], h1[3]); \
                                *(u32x4*)(HB + (size_t)(R) * DM + 512 * j + 8 * lane) = w_; } } } while (0)
                    if (x_from_in) {
#pragma unroll 1
                        for (int pass = 0; pass < 2; ++pass) {
                            const int r = rb + wave * 4 + pass * 2;
                            f32x4 xa[8], xb[8]; u32x4 ma[4], mb[4];
                            const float* xr = r < NCTX ? KARG_IN(I_XP) + (size_t)r * DM : KARG_IN(I_XS) + (size_t)(r - NCTX) * DM;
#pragma unroll
                            for (int k = 0; k < 8; ++k) { xa[k] = __builtin_nontemporal_load((const f32x4*)(xr + 512 * (k >> 1) + 8 * lane + 4 * (k & 1))); xb[k] = __builtin_nontemporal_load((const f32x4*)(xr + DM + 512 * (k >> 1) + 8 * lane + 4 * (k & 1))); }
                            if (has_post) {
#pragma unroll
                                for (int j = 0; j < 4; ++j) { ma[j] = __builtin_nontemporal_load((const u32x4*)(MB + (size_t)r * DM + 512 * j + 8 * lane)); mb[j] = __builtin_nontemporal_load((const u32x4*)(MB + (size_t)(r + 1) * DM + 512 * j + 8 * lane)); }
                            } else {
#pragma unroll
                                for (int j = 0; j < 4; ++j) { ma[j] = (u32x4){0u, 0u, 0u, 0u}; mb[j] = (u32x4){0u, 0u, 0u, 0u}; }
                            }
                            NR_ROW(xa, ma, r); NR_ROW(xb, mb, r + 1);
                        }
                    } else {
                        const int r = rb + wave * 4;
                        u32x4 xw[4][4], mw[4][4];
#pragma unroll
                        for (int q = 0; q < 4; ++q)
#pragma unroll
                            for (int j = 0; j < 4; ++j) { xw[q][j] = __builtin_nontemporal_load((const u32x4*)(XB + (size_t)(r + q) * DM + 512 * j + 8 * lane)); mw[q][j] = __builtin_nontemporal_load((const u32x4*)(MB + (size_t)(r + q) * DM + 512 * j + 8 * lane)); }
#pragma unroll
                        for (int q = 0; q < 4; ++q) { f32x4 xa[8];
#pragma unroll
                            for (int j = 0; j < 4; ++j) NR_UNPK(xw[q][j], xa[2 * j], xa[2 * j + 1]);
                            NR_ROW(xa, mw[q], r + q); }
                    }
#undef NR_UNPK
#undef NR_ROW
                }
                __syncthreads();
            }
            PH_END(pid)
            if (half == 1) {
                PH_BEGIN(pbase + 6)
                { pg8::Gemm g{HB, WGU + (size_t)l * 2 * FFH * DM, DM, DM, DM, 31}; pg8::StaticOrder S; S.init(MTOK, 2 * FFH, G, bid);
                  pg8::EpiSwiglu E{BIG, FFH}; pg8::gemm_phase<pg8::EpiSwiglu, pg8::StaticOrder>(lds, g, S, E, tid); }
                PH_END(pbase + 6)
                PH_BEGIN(pbase + 7)
                { pg8::Gemm g{BIG, WDN + (size_t)l * DM * FFH, FFH, FFH, FFH, 31}; pg8::StaticOrder S; S.init(MTOK, DM, G, bid, 4);
                  pg8::EpiM E{MB, DM, nullptr}; pg8::gemm_phase<pg8::EpiM, pg8::StaticOrder>(lds, g, S, E, tid); }
                PH_END(pbase + 7)
            }
        }
    }
#undef PH_BEGIN
#undef PH_END
}

static bool phase_nonempty(int id) {
    if (id < 2 || id == 34) return true;
    const int l = (id - 2) / 8, k = (id - 2) % 8, kind = l % 3;
    if (k == 2) return kind != 2;
    if (k == 3) return kind == 1;
    return true;
}
extern "C" void kernel_launch(void* const* d_in, const int* in_sizes, int n_in, void* d_out, int out_size, void* d_ws, size_t ws_size, hipStream_t stream) {
    static int grid = 0;
    if (grid == 0) {
        if (n_in != 25 || ws_size < WS_END) { fprintf(stderr, "kernel_launch: expected 25 inputs and >= %zu bytes of workspace; got n_in %d ws %zu\n", (size_t)WS_END, n_in, ws_size); grid = -1; return; }
        int dev = 0, cus = 0, per_cu = 0;
        if (hipGetDevice(&dev) != hipSuccess || hipDeviceGetAttribute(&cus, hipDeviceAttributeMultiprocessorCount, dev) != hipSuccess) { grid = -1; return; }
        if (hipFuncSetAttribute((const void*)fwd, hipFuncAttributeMaxDynamicSharedMemorySize, LDS_BYTES) != hipSuccess) { fprintf(stderr, "kernel_launch: hipFuncSetAttribute failed\n"); grid = -1; return; }
        if (hipOccupancyMaxActiveBlocksPerMultiprocessor(&per_cu, (const void*)fwd, NTHR, LDS_BYTES) != hipSuccess || per_cu < 1) { fprintf(stderr, "kernel_launch: occupancy query says %d\n", per_cu); }
        (void)hipGetLastError();
        grid = cus;
    }
    if (grid < 0) return;
    (void)hipMemsetAsync((char*)d_ws + WS_CTL, 0, CTL_ZERO_BYTES, stream);
    Args a{};
    for (int i = 0; i < 25; ++i) a.in[i] = (const float*)d_in[i];
    a.out = (float*)d_out; a.ws = (unsigned char*)d_ws;
#if MK_ONE_LAUNCH
    a.ph_lo = 0; a.ph_hi = NPHASE;
    hipLaunchKernelGGL(fwd, dim3(grid), dim3(NTHR), LDS_BYTES, stream, a);
#else
    for (int id = 0; id < NPHASE; ++id) {
        if (!phase_nonempty(id)) continue;
        a.ph_lo = id; a.ph_hi = id + 1;
        hipLaunchKernelGGL(fwd, dim3(grid), dim3(NTHR), LDS_BYTES, stream, a);
    }
#endif
    const hipError_t le = hipPeekAtLastError();
    if (le != hipSuccess) fprintf(stderr, "kernel_launch: launch failed: %s\n", hipGetErrorName(le));
}
```

```cpp
#include <hip/hip_runtime.h>
#include <cstdio>
#include <cstdint>

#ifndef MK_ONE_LAUNCH
#define MK_ONE_LAUNCH 1
#endif

#define GAS __attribute__((address_space(1)))
#define LAS __attribute__((address_space(3)))
typedef unsigned short bf16_t;
typedef short bf16x8 __attribute__((ext_vector_type(8)));
typedef short s16x4 __attribute__((ext_vector_type(4)));
typedef float f32x2 __attribute__((ext_vector_type(2)));
typedef float f32x4 __attribute__((ext_vector_type(4)));
typedef float f32x8 __attribute__((ext_vector_type(8)));
typedef float f32x16 __attribute__((ext_vector_type(16)));
typedef unsigned u32x2 __attribute__((ext_vector_type(2)));
typedef unsigned u32x4 __attribute__((ext_vector_type(4)));

constexpr int DM = 2048, FFH = 5632, NCTX = 8192, NLAT = 32768, MTOK = NCTX + NLAT;
constexpr int LAT_B = 8, LAT_T = 4096, PAST = 512, KV_T = LAT_T + PAST;
constexpr int KVROWS = NCTX + LAT_B * KV_T;
constexpr int NCOND = 9, NMOD = 6, MODW = NMOD * DM;
constexpr float EPS = 1e-6f;
constexpr int NWAVES = 8, NTHR = 512;
constexpr size_t OUT_SK = (size_t)MTOK * DM, OUT_SV = OUT_SK + (size_t)NCTX * 512;

constexpr size_t MiB = 1u << 20;
constexpr size_t WS_CTL = 0, CTL_ZERO_BYTES = 1 * MiB;
constexpr size_t WS_MODP = 1 * MiB;
constexpr size_t WS_MOD = 15 * MiB;
constexpr size_t WS_ROPE = 17 * MiB;
constexpr size_t WS_VSS = 18 * MiB;
constexpr size_t WS_WGU = 32 * MiB;
constexpr size_t WS_WDN = 208 * MiB;
constexpr size_t WS_WIN = 296 * MiB;
constexpr size_t WS_WOUT = 328 * MiB;
constexpr size_t WS_WQKV = 344 * MiB;
constexpr size_t WS_WO = 356 * MiB;
constexpr size_t WS_WPOOL = 364 * MiB;
constexpr size_t WS_H = 368 * MiB;
constexpr size_t WS_MB = 528 * MiB;
constexpr size_t WS_BIG = 688 * MiB;
constexpr size_t WS_KB = 1128 * MiB;
constexpr size_t WS_VB = 1172 * MiB;
constexpr size_t WS_XB = 1216 * MiB;
constexpr size_t WS_END = 1376 * MiB;
constexpr size_t BIG_V = 160 * MiB, BIG_KR = 160 * MiB, BIG_VR = 200 * MiB;
constexpr int CW_TMO = 0, CW_BAR = 4096;

constexpr int RING_BYTES = 131072;
constexpr int LDS_BYTES = 147456;
constexpr int MISC_OFF = LDS_BYTES - 256;

template <int CTRL> __device__ __forceinline__ float dpp_get(float v) { return __builtin_bit_cast(float, __builtin_amdgcn_update_dpp(0, __builtin_bit_cast(int, v), CTRL, 0xf, 0xf, true)); }
__device__ __forceinline__ float row16_sum(float v) { v += dpp_get<0xB1>(v); v += dpp_get<0x4E>(v); v += dpp_get<0x141>(v); v += dpp_get<0x140>(v); return v; }
__device__ __forceinline__ float wave_sum(float v) {
    v = row16_sum(v);
    const float a = __builtin_bit_cast(float, __builtin_amdgcn_readlane(__builtin_bit_cast(int, v), 0)), b = __builtin_bit_cast(float, __builtin_amdgcn_readlane(__builtin_bit_cast(int, v), 16));
    const float c = __builtin_bit_cast(float, __builtin_amdgcn_readlane(__builtin_bit_cast(int, v), 32)), d = __builtin_bit_cast(float, __builtin_amdgcn_readlane(__builtin_bit_cast(int, v), 48));
    return (a + b) + (c + d);
}
__device__ __forceinline__ unsigned cvt_pk_bf16(float lo, float hi) { unsigned r; asm volatile("v_cvt_pk_bf16_f32 %0, %1, %2" : "=v"(r) : "v"(lo), "v"(hi)); return r; }
__device__ __forceinline__ float bflo(unsigned w) { return __builtin_bit_cast(float, w << 16); }
__device__ __forceinline__ float bfhi(unsigned w) { return __builtin_bit_cast(float, w & 0xffff0000u); }
__device__ __forceinline__ unsigned short f2bf(float f) { unsigned u = __builtin_bit_cast(unsigned, f); return (unsigned short)((u + 0x7fffu + ((u >> 16) & 1u)) >> 16); }
__device__ __forceinline__ float silu_f(float g) { return g * __builtin_amdgcn_rcpf(1.0f + __builtin_amdgcn_exp2f(-1.4426950408889634f * g)); }

namespace pg8 {
constexpr int BM = 256, BK = 64, HALF = 128, HTB = HALF * BK * 2, STAGE_BYTES = 8 * HTB, NXCD = 8, WGM = 8;
__host__ __device__ __forceinline__ int lds_byte(int r, int c) { const int st = (r >> 4) * 2 + (c >> 5), rr = r & 15, cc = c & 31, ob = rr * 64 + cc * 2; return st * 1024 + (ob ^ (((ob >> 9) & 1) << 5)); }
__host__ __device__ __forceinline__ void stage_rc(int b, int& R, int& C) { const int st = b / 1024, sb = b % 1024, swz = sb ^ (((sb >> 9) & 1) << 5); R = (st >> 1) * 16 + swz / 64; C = (st & 1) * 32 + (swz % 64) / 2; }
__host__ __device__ __forceinline__ int perm32(int rho) { const int n = rho >> 4, i = rho & 15; return 8 * (i >> 2) + 4 * n + (i & 3); }

struct Unit { int pm, pn; };
struct Gemm { const bf16_t* A; const bf16_t* Bt; int lda, ldb, K, gshift; };

struct StaticOrder {
    int nM, nN, nwg, G, c, wgm;
    __host__ __device__ void init(int M, int N, int G_, int c_, int wgm_ = WGM) { nM = M / BM; nN = N / BM; nwg = nM * nN; G = G_; c = c_; wgm = wgm_; }
    __host__ __device__ bool next(int i, Unit& u) const {
        const long L = (long)i * G + c; if (L >= nwg) return false;
        int wgid = (int)L; { const int q = nwg / NXCD, r = nwg % NXCD, xcd = wgid % NXCD, off = wgid / NXCD; wgid = (xcd < r ? xcd * (q + 1) : r * (q + 1) + (xcd - r) * q) + off; }
        const int nig = wgm * nN, gid = wgid / nig, fm = gid * wgm, gsz = (nM - fm) < wgm ? (nM - fm) : wgm;
        u.pm = fm + ((wgid % nig) % gsz); u.pn = (wgid % nig) / gsz; return true;
    }
};

struct EpiM {
    bf16_t* O; int ldc; const float* cscale;
    __device__ __forceinline__ void operator()(const f32x4 (&acc)[2][2][4][2], const Unit& u, int wr, int wc, int fr, int fq) const {
        const int row0 = u.pm * BM + wr * 64 + fr, col0 = u.pn * BM + wc * 32 + 8 * fq;
        f32x4 sv[2][2];
#pragma unroll
        for (int bj = 0; bj < 2; ++bj)
#pragma unroll
            for (int n = 0; n < 2; ++n) sv[bj][n] = cscale ? *(const f32x4*)(cscale + col0 + bj * HALF + 4 * n) : (f32x4){1.f, 1.f, 1.f, 1.f};
#pragma unroll
        for (int ai = 0; ai < 2; ++ai)
#pragma unroll
            for (int m = 0; m < 4; ++m) { bf16_t* rowp = O + (size_t)(row0 + ai * HALF + m * 16) * ldc + col0;
#pragma unroll
                for (int bj = 0; bj < 2; ++bj) { const f32x4 v0 = acc[ai][bj][m][0] * sv[bj][0], v1 = acc[ai][bj][m][1] * sv[bj][1];
                    u32x4 w; w.x = cvt_pk_bf16(v0[0], v0[1]); w.y = cvt_pk_bf16(v0[2], v0[3]); w.z = cvt_pk_bf16(v1[0], v1[1]); w.w = cvt_pk_bf16(v1[2], v1[3]);
                    *(u32x4*)(rowp + bj * HALF) = w; } }
    }
};
struct EpiUV {
    bf16_t* U; bf16_t* V; float* vss;
    __device__ __forceinline__ void operator()(const f32x4 (&acc)[2][2][4][2], const Unit& u, int wr, int wc, int fr, int fq) const {
        const bool isv = u.pn >= 8;
        const int row0 = u.pm * BM + wr * 64 + fr, col0 = (u.pn & 7) * BM + wc * 32 + 8 * fq;
        bf16_t* base = isv ? V : U;
#pragma unroll
        for (int ai = 0; ai < 2; ++ai)
#pragma unroll
            for (int m = 0; m < 4; ++m) { const int row = row0 + ai * HALF + m * 16; bf16_t* rowp = base + (size_t)row * DM + col0; float ss = 0.f;
#pragma unroll
                for (int bj = 0; bj < 2; ++bj) { const f32x4 v0 = acc[ai][bj][m][0], v1 = acc[ai][bj][m][1];
                    ss += (v0[0] * v0[0] + v0[1] * v0[1]) + (v0[2] * v0[2] + v0[3] * v0[3]) + (v1[0] * v1[0] + v1[1] * v1[1]) + (v1[2] * v1[2] + v1[3] * v1[3]);
                    u32x4 w; w.x = cvt_pk_bf16(v0[0], v0[1]); w.y = cvt_pk_bf16(v0[2], v0[3]); w.z = cvt_pk_bf16(v1[0], v1[1]); w.w = cvt_pk_bf16(v1[2], v1[3]);
                    *(u32x4*)(rowp + bj * HALF) = w; }
                if (isv) { ss += __shfl_xor(ss, 16); ss += __shfl_xor(ss, 32); if (fq == 0) vss[(size_t)row * 32 + (u.pn - 8) * 4 + wc] = ss; } }
    }
};
struct EpiQKV {
    bf16_t* Q; bf16_t* Kr; bf16_t* Vb; float* sv;
    __device__ __forceinline__ void operator()(const f32x4 (&acc)[2][2][4][2], const Unit& u, int wr, int wc, int fr, int fq) const {
        bf16_t* base; int ldc, ct; int radd = 0; const bool isv = u.pn >= 10, ctx = u.pm < 32;
        if (u.pn < 8) { base = Q; ldc = DM; ct = u.pn; } else if (u.pn < 10) { base = Kr; ldc = 512; ct = u.pn - 8; } else { base = Vb; ldc = 512; ct = u.pn - 10; radd = ctx ? 0 : ((u.pm - 32) >> 4) * 512; }
        const int row0 = u.pm * BM + wr * 64 + fr, col0 = ct * BM + wc * 32 + 8 * fq;
#pragma unroll
        for (int ai = 0; ai < 2; ++ai)
#pragma unroll
            for (int m = 0; m < 4; ++m) { const int row = row0 + ai * HALF + m * 16; bf16_t* rowp = base + (size_t)(row + radd) * ldc + col0;
#pragma unroll
                for (int bj = 0; bj < 2; ++bj) { const f32x4 v0 = acc[ai][bj][m][0], v1 = acc[ai][bj][m][1];
                    u32x4 w; w.x = cvt_pk_bf16(v0[0], v0[1]); w.y = cvt_pk_bf16(v0[2], v0[3]); w.z = cvt_pk_bf16(v1[0], v1[1]); w.w = cvt_pk_bf16(v1[2], v1[3]);
                    *(u32x4*)(rowp + bj * HALF) = w;
                    if (isv && ctx) { float* sp = sv + (size_t)row * 512 + col0 + bj * HALF; *(f32x4*)sp = v0; *(f32x4*)(sp + 4) = v1; } } }
    }
};
struct EpiSwiglu {
    bf16_t* O; int ldc;
    __device__ __forceinline__ void operator()(const f32x4 (&acc)[2][2][4][2], const Unit& u, int wr, int wc, int fr, int fq) const {
        const int row0 = u.pm * BM + wr * 64 + fr, col0 = u.pn * HALF + wc * 32 + 8 * fq;
#pragma unroll
        for (int ai = 0; ai < 2; ++ai)
#pragma unroll
            for (int m = 0; m < 4; ++m) { bf16_t* rowp = O + (size_t)(row0 + ai * HALF + m * 16) * ldc + col0;
                const f32x4 g0 = acc[ai][0][m][0], g1 = acc[ai][0][m][1], u0 = acc[ai][1][m][0], u1 = acc[ai][1][m][1];
                u32x4 w;
                w.x = cvt_pk_bf16(silu_f(g0[0]) * u0[0], silu_f(g0[1]) * u0[1]); w.y = cvt_pk_bf16(silu_f(g0[2]) * u0[2], silu_f(g0[3]) * u0[3]);
                w.z = cvt_pk_bf16(silu_f(g1[0]) * u1[0], silu_f(g1[1]) * u1[1]); w.w = cvt_pk_bf16(silu_f(g1[2]) * u1[2], silu_f(g1[3]) * u1[3]);
                *(u32x4*)rowp = w; }
    }
};

template <class Epi, class Sched>
__device__ __forceinline__ void gemm_phase(LAS unsigned char* lds, const Gemm g, const Sched& S, const Epi& E, const int tid) {
    const int wid = __builtin_amdgcn_readfirstlane(tid >> 6), lane = tid & 63, wr = wid >> 2, wc = wid & 3, fr = lane & 15, fq = lane >> 4;
    const int K = g.K, nt = K / BK;
    unsigned voffA[2], voffB[2];
#pragma unroll
    for (int i = 0; i < 2; ++i) { int R, C; stage_rc(tid * 16 + i * 8192, R, C); const int Rb = (R & ~31) + perm32(R & 31);
        voffA[i] = (unsigned)(R * g.lda + C) * 2u; voffB[i] = (unsigned)(Rb * g.ldb + C) * 2u; }
    const size_t kstep = (size_t)(BK * 2);
    const size_t hstepA = (size_t)HALF * g.lda * 2, hstepB = (size_t)HALF * g.ldb * 2;
    const unsigned ldsw = (unsigned)wid * 1024u;
    const int aoff = lds_byte(wr * 64 + fr, fq * 8), boff = lds_byte(wc * 32 + fr, fq * 8);
#define PG8_UA(u) ((const char*)g.A + (size_t)(u).pm * (2 * hstepA) + (size_t)((u).pn >> g.gshift) * (size_t)K * 2)
#define PG8_UB(u) ((const char*)g.Bt + (size_t)(u).pn * (2 * hstepB))
#define PG8_SA(b, h) (((b) * 2 + (h)) * HTB)
#define PG8_SB(b, h) ((4 + (b) * 2 + (h)) * HTB)
#define PG8_STAGE(bufoff, gbase, voff) do { _Pragma("unroll") for (int _i = 0; _i < 2; ++_i) \
        __builtin_amdgcn_global_load_lds((const unsigned*)((const char*)(gbase) + (voff)[_i]), (LAS unsigned*)(lds + (bufoff) + ldsw + _i * 8192), 16, 0, 0); } while (0)
#define PG8_LDA(dst, b, h) do { _Pragma("unroll") for (int m = 0; m < 4; ++m) _Pragma("unroll") for (int k = 0; k < 2; ++k) dst[m][k] = *(const LAS bf16x8*)(lds + PG8_SA(b, h) + aoff + m * 2048 + k * 1024); } while (0)
#define PG8_LDB(dst, b, h) do { _Pragma("unroll") for (int n = 0; n < 2; ++n) _Pragma("unroll") for (int k = 0; k < 2; ++k) dst[n][k] = *(const LAS bf16x8*)(lds + PG8_SB(b, h) + boff + n * 2048 + k * 1024); } while (0)
#define PG8_MMA(ai, bj, At, Bt) do { __builtin_amdgcn_s_setprio(1); _Pragma("unroll") for (int m = 0; m < 4; ++m) _Pragma("unroll") for (int n = 0; n < 2; ++n) _Pragma("unroll") for (int k = 0; k < 2; ++k) \
        acc[ai][bj][m][n] = __builtin_amdgcn_mfma_f32_16x16x32_bf16(Bt[n][k], At[m][k], acc[ai][bj][m][n], 0, 0, 0); __builtin_amdgcn_s_setprio(0); } while (0)
#define PG8_WAIT_V(n) asm volatile("s_waitcnt vmcnt(" #n ")" ::: "memory")
#define PG8_WAIT_L(n) asm volatile("s_waitcnt lgkmcnt(" #n ")" ::: "memory")
#define PG8_BAR __builtin_amdgcn_s_barrier()
#define PG8_SCHED __builtin_amdgcn_sched_barrier(0)
    Unit cur, nxt; int ui = 0;
    if (!S.next(0, cur)) return;
    f32x4 acc[2][2][4][2];
#pragma unroll
    for (int a = 0; a < 2; ++a)
#pragma unroll
        for (int b = 0; b < 2; ++b)
#pragma unroll
            for (int m = 0; m < 4; ++m)
#pragma unroll
                for (int n = 0; n < 2; ++n) acc[a][b][m][n] = (f32x4){0.f, 0.f, 0.f, 0.f};
    bf16x8 At[4][2], B0[2][2], B1[2][2];
    const char* cA = PG8_UA(cur); const char* cB = PG8_UB(cur);
    PG8_STAGE(PG8_SB(0, 0), cB, voffB); PG8_STAGE(PG8_SB(0, 1), cB + hstepB, voffB); PG8_STAGE(PG8_SA(0, 0), cA, voffA); PG8_STAGE(PG8_SA(0, 1), cA + hstepA, voffA);
    if (wr == 1) PG8_BAR;
    PG8_WAIT_V(2); PG8_BAR;
    PG8_STAGE(PG8_SB(1, 0), cB + kstep, voffB); PG8_STAGE(PG8_SA(1, 0), cA + kstep, voffA); PG8_STAGE(PG8_SB(1, 1), cB + hstepB + kstep, voffB);
    PG8_WAIT_V(6); PG8_BAR;
    for (;;) {
        const bool has_next = S.next(ui + 1, nxt);
        const char* nA = has_next ? PG8_UA(nxt) : cA; const char* nB = has_next ? PG8_UB(nxt) : cB;
        for (int t = 0; t < nt; t += 2) {
            const bool last = (t == nt - 2);
            const char* a1 = cA + (size_t)(t + 1) * kstep;
            const char* a2 = last ? nA : cA + (size_t)(t + 2) * kstep; const char* b2 = last ? nB : cB + (size_t)(t + 2) * kstep;
            const char* a3 = a2 + kstep; const char* b3 = b2 + kstep;
            PG8_LDB(B0, 0, 0); PG8_LDB(B1, 0, 1); PG8_SCHED; PG8_LDA(At, 0, 0); PG8_STAGE(PG8_SA(1, 1), a1 + hstepA, voffA);
            PG8_WAIT_V(8); PG8_WAIT_L(0); PG8_BAR; PG8_MMA(0, 0, At, B0); PG8_MMA(0, 1, At, B1); PG8_BAR; PG8_SCHED;
            PG8_LDA(At, 0, 1); PG8_STAGE(PG8_SB(0, 0), b2, voffB); PG8_STAGE(PG8_SB(0, 1), b2 + hstepB, voffB); PG8_STAGE(PG8_SA(0, 0), a2, voffA);
            PG8_WAIT_V(8); PG8_WAIT_L(0); PG8_BAR; PG8_MMA(1, 0, At, B0); PG8_MMA(1, 1, At, B1); PG8_BAR; PG8_SCHED;
            PG8_LDB(B0, 1, 0); PG8_LDB(B1, 1, 1); PG8_SCHED; PG8_LDA(At, 1, 0); PG8_STAGE(PG8_SA(0, 1), a2 + hstepA, voffA);
            PG8_WAIT_V(8); PG8_WAIT_L(0); PG8_BAR; PG8_MMA(0, 0, At, B0); PG8_MMA(0, 1, At, B1); PG8_BAR; PG8_SCHED;
            PG8_LDA(At, 1, 1); PG8_STAGE(PG8_SB(1, 0), b3, voffB); PG8_STAGE(PG8_SB(1, 1), b3 + hstepB, voffB); PG8_STAGE(PG8_SA(1, 0), a3, voffA);
            PG8_WAIT_V(8); PG8_WAIT_L(0); PG8_BAR; PG8_MMA(1, 0, At, B0); PG8_MMA(1, 1, At, B1); PG8_BAR; PG8_SCHED;
        }
        if (wr == 0) PG8_BAR;
        E(acc, cur, wr, wc, fr, fq);
        if (!has_next) break;
#pragma unroll
        for (int a = 0; a < 2; ++a)
#pragma unroll
            for (int b = 0; b < 2; ++b)
#pragma unroll
                for (int m = 0; m < 4; ++m)
#pragma unroll
                    for (int n = 0; n < 2; ++n) acc[a][b][m][n] = (f32x4){0.f, 0.f, 0.f, 0.f};
        cur = nxt; cA = nA; cB = nB; ++ui;
        if (wr == 1) PG8_BAR;
    }
    PG8_WAIT_V(0);
    PG8_BAR;
#undef PG8_UA
#undef PG8_UB
#undef PG8_SA
#undef PG8_SB
#undef PG8_STAGE
#undef PG8_LDA
#undef PG8_LDB
#undef PG8_MMA
#undef PG8_WAIT_V
#undef PG8_WAIT_L
#undef PG8_BAR
#undef PG8_SCHED
}
}

namespace att {
constexpr int D = 128, NW = 8, QBLK = 32, KVBLK = 64;
constexpr float SCALE = 0.088388347648318440f;
constexpr float THR = 8.f;
constexpr int LDQ = 2048, LDK = 512, LDO = 2048;
constexpr size_t SHM_V = KVBLK * D * 2, SHM_K = KVBLK * D * 2, SHM_ATTN = 2 * SHM_V + 2 * SHM_K + NW * 64 * 4;
#define KSWZ(row, colB) ((row) * 256 + ((colB) ^ (((row) & 7) << 4)))
#define SBAR() __builtin_amdgcn_sched_barrier(0)
__device__ __forceinline__ int crow(int r, int hi) { return (r & 3) + 8 * (r >> 2) + 4 * hi; }
__device__ __forceinline__ unsigned cvtpk(float lo, float hi) { unsigned r; asm volatile("v_cvt_pk_bf16_f32 %0, %1, %2" : "=v"(r) : "v"(lo), "v"(hi)); return r; }
__device__ __forceinline__ bf16x8 ld8(const bf16_t* p) { return *reinterpret_cast<const bf16x8*>(p); }

__device__ __forceinline__ void partialSM(f32x16& p0, f32x16& p1, float& m_reg, f32x16& negm, float& alpha) {
  constexpr float THR2 = THR * 1.4426950408889634f;
  float pmax = p0[0];
#pragma unroll
  for (int r = 1; r < 16; ++r) pmax = fmaxf(pmax, p0[r]);
#pragma unroll
  for (int r = 0; r < 16; ++r) pmax = fmaxf(pmax, p1[r]);
  { auto rr = __builtin_amdgcn_permlane32_swap(__float_as_uint(pmax), __float_as_uint(pmax), false, false);
    pmax = fmaxf(__uint_as_float(rr[0]), __uint_as_float(rr[1])); }
  if (__builtin_expect(__all(pmax <= THR2), 1)) { alpha = 1.f; }
  else { const float d = fmaxf(pmax, 0.f); m_reg += d; alpha = __builtin_amdgcn_exp2f(-d);
#pragma unroll
    for (int r = 0; r < 16; ++r) { p0[r] -= d; p1[r] -= d; }
#pragma unroll
    for (int r = 0; r < 16; ++r) negm[r] = -m_reg;
    asm volatile("" : "+v"(negm)); }
#pragma unroll
  for (int r = 0; r < 16; ++r) p0[r] = __builtin_amdgcn_exp2f(p0[r]);
}
__device__ __forceinline__ void finishSM(f32x16& p0, f32x16& p1, float alpha, float& l_reg, bf16x8& pa0, bf16x8& pa1, bf16x8& pa2, bf16x8& pa3) {
#pragma unroll
  for (int r = 0; r < 16; ++r) p1[r] = __builtin_amdgcn_exp2f(p1[r]);
  f32x2 ps2 = (f32x2){p0[0], p0[1]} + (f32x2){p1[0], p1[1]};
#pragma unroll
  for (int r = 2; r < 16; r += 2) { ps2 += (f32x2){p0[r], p0[r + 1]}; ps2 += (f32x2){p1[r], p1[r + 1]}; }
  float ps = ps2.x + ps2.y;
  { auto rr = __builtin_amdgcn_permlane32_swap(__float_as_uint(ps), __float_as_uint(ps), false, false);
    ps = __uint_as_float(rr[0]) + __uint_as_float(rr[1]); }
  l_reg = l_reg * alpha + ps;
#define PK4(P, BASE, OUT) do { unsigned a0 = cvtpk(P[BASE + 0], P[BASE + 1]), a1 = cvtpk(P[BASE + 2], P[BASE + 3]);   \
    unsigned b0 = cvtpk(P[BASE + 4], P[BASE + 5]), b1 = cvtpk(P[BASE + 6], P[BASE + 7]);                              \
    auto r0 = __builtin_amdgcn_permlane32_swap(a0, b0, false, false); auto r1 = __builtin_amdgcn_permlane32_swap(a1, b1, false, false); \
    u32x4 w = {r0[0], r1[0], r0[1], r1[1]}; OUT = *reinterpret_cast<bf16x8*>(&w); } while (0)
  PK4(p0, 0, pa0); PK4(p0, 8, pa1); PK4(p1, 0, pa2); PK4(p1, 8, pa3);
#undef PK4
}
__device__ __forceinline__ void qkt(f32x16& p0, f32x16& p1, const LAS char* Ks, const bf16x8* qr, const f32x16& negm, int r32, int hi) {
#pragma unroll
  for (int dl = 0; dl < 4; ++dl) { const LAS char* kb_ = Ks + KSWZ(r32, (dl * 16 + hi * 8) * 2);
#pragma unroll
    for (int dh = 0; dh < 2; ++dh) { const int d0 = dl + 4 * dh;
      bf16x8 b0 = *(const LAS bf16x8*)(kb_ + dh * 128);
      bf16x8 b1 = *(const LAS bf16x8*)(kb_ + dh * 128 + 8192);
      if (dl == 0 && dh == 0) { p0 = __builtin_amdgcn_mfma_f32_32x32x16_bf16(b0, qr[d0], negm, 0, 0, 0); p1 = __builtin_amdgcn_mfma_f32_32x32x16_bf16(b1, qr[d0], negm, 0, 0, 0); }
      else { p0 = __builtin_amdgcn_mfma_f32_32x32x16_bf16(b0, qr[d0], p0, 0, 0, 0); p1 = __builtin_amdgcn_mfma_f32_32x32x16_bf16(b1, qr[d0], p1, 0, 0, 0); } } }
}
__device__ __forceinline__ int v_st(int k, int c) { const int kk = (k & ~0xC) | ((k & 4) << 1) | ((k & 8) >> 1); return ((kk >> 3) * 4 + (c >> 5)) * 512 + ((kk & 7) * 32 + (c & 31)) * 2; }
__device__ __forceinline__ int v_rd_base(int lane) { return ((lane & 3) << 3) | (((lane >> 2) & 3) << 6) | (((lane >> 4) & 1) << 5) | (((lane >> 5) & 1) << 8); }
constexpr int v_rd_off(int d0, int ks, int half) { return d0 * 512 + ks * 4096 + half * 2048; }
template <int OFF> __device__ __forceinline__ s16x4 tr_read(int vb) {
  s16x4 r; asm volatile("ds_read_b64_tr_b16 %0, %1 offset:%2" : "=&v"(r) : "v"(vb), "i"(OFF) : "memory"); return r;
}
template <int D0> __device__ __forceinline__ void pv_one(f32x16& od, int vb, bf16x8 pa0, bf16x8 pa1, bf16x8 pa2, bf16x8 pa3) {
  const s16x4 l0 = tr_read<v_rd_off(D0, 0, 0)>(vb), h0 = tr_read<v_rd_off(D0, 0, 1)>(vb), l1 = tr_read<v_rd_off(D0, 1, 0)>(vb), h1 = tr_read<v_rd_off(D0, 1, 1)>(vb);
  const s16x4 l2 = tr_read<v_rd_off(D0, 2, 0)>(vb), h2 = tr_read<v_rd_off(D0, 2, 1)>(vb), l3 = tr_read<v_rd_off(D0, 3, 0)>(vb), h3 = tr_read<v_rd_off(D0, 3, 1)>(vb);
  asm volatile("s_waitcnt lgkmcnt(0)" ::: "memory"); SBAR();
#define PK(L, H) (bf16x8){L[0], L[1], L[2], L[3], H[0], H[1], H[2], H[3]}
  od = __builtin_amdgcn_mfma_f32_32x32x16_bf16(pa0, PK(l0, h0), od, 0, 0, 0);
  od = __builtin_amdgcn_mfma_f32_32x32x16_bf16(pa1, PK(l1, h1), od, 0, 0, 0);
  od = __builtin_amdgcn_mfma_f32_32x32x16_bf16(pa2, PK(l2, h2), od, 0, 0, 0);
  od = __builtin_amdgcn_mfma_f32_32x32x16_bf16(pa3, PK(l3, h3), od, 0, 0, 0);
#undef PK
}
__device__ __forceinline__ void pv_d0(f32x16* o, int vb, bf16x8 pa0, bf16x8 pa1, bf16x8 pa2, bf16x8 pa3) {
  pv_one<0>(o[0], vb, pa0, pa1, pa2, pa3); pv_one<1>(o[1], vb, pa0, pa1, pa2, pa3); pv_one<2>(o[2], vb, pa0, pa1, pa2, pa3); pv_one<3>(o[3], vb, pa0, pa1, pa2, pa3);
}

__device__ __forceinline__ void attn_dense_body(const bf16_t* __restrict__ Qb, const bf16_t* __restrict__ Kh, const bf16_t* __restrict__ Vh, bf16_t* __restrict__ Ob, int seq, LAS char* lds, const int tid, const float* __restrict__ qn, const f32x2* __restrict__ rope, const int t0  ) {
  const int wid = tid >> 6, lane = tid & 63, r32 = lane & 31, hi = lane >> 5;
  LAS char* V_lds = lds; LAS char* K_lds = lds + 2 * SHM_V;
  LAS float* ws = (LAS float*)(lds + 2 * SHM_V + 2 * SHM_K) + wid * 64; LAS float* li_l = ws; LAS float* al_l = ws + 32;
  float m_reg = 0.f, l_reg = 0; f32x16 o[4] = {}; bf16x8 qr[8]; f32x16 negm = {}; asm volatile("" : "+v"(negm));
  const bf16_t* Qw = Qb + (long)(wid * QBLK + r32) * LDQ + hi * 8;
#pragma unroll
  for (int d0 = 0; d0 < 8; ++d0) qr[d0] = ld8(Qw + d0 * 16);
  {
    float ss = 0.f;
#pragma unroll
    for (int d0 = 0; d0 < 8; ++d0) { const u32x4 w = __builtin_bit_cast(u32x4, qr[d0]);
      const float a0 = bflo(w.x), a1 = bfhi(w.x), a2 = bflo(w.y), a3 = bfhi(w.y), a4 = bflo(w.z), a5 = bfhi(w.z), a6 = bflo(w.w), a7 = bfhi(w.w);
      ss += (a0 * a0 + a1 * a1) + (a2 * a2 + a3 * a3) + (a4 * a4 + a5 * a5) + (a6 * a6 + a7 * a7); }
    { auto rr = __builtin_amdgcn_permlane32_swap(__float_as_uint(ss), __float_as_uint(ss), false, false); ss = __uint_as_float(rr[0]) + __uint_as_float(rr[1]); }
    const float rstd = (SCALE * 1.4426950408889634f) / sqrtf(ss * (1.0f / 128.0f) + 1e-6f);
    const int t = t0 + wid * QBLK + r32, prow = t >> 6, pcol = t & 63;
#pragma unroll
    for (int d0 = 0; d0 < 8; ++d0) { const u32x4 w = __builtin_bit_cast(u32x4, qr[d0]);
      const f32x4 g0 = *(const f32x4*)(qn + d0 * 16 + hi * 8), g1 = *(const f32x4*)(qn + d0 * 16 + hi * 8 + 4);
      float y0 = bflo(w.x) * rstd * g0[0], y1 = bfhi(w.x) * rstd * g0[1], y2 = bflo(w.y) * rstd * g0[2], y3 = bfhi(w.y) * rstd * g0[3];
      float y4 = bflo(w.z) * rstd * g1[0], y5 = bfhi(w.z) * rstd * g1[1], y6 = bflo(w.w) * rstd * g1[2], y7 = bfhi(w.w) * rstd * g1[3];
      if (t0 >= 0) { const f32x2* cs = rope + (d0 < 4 ? prow : pcol) * 32 + (d0 & 3) * 8 + hi * 4;
        const f32x2 c0 = cs[0], c1 = cs[1], c2 = cs[2], c3 = cs[3]; float x1, x2;
        x1 = y0; x2 = y1; y0 = x1 * c0.x - x2 * c0.y; y1 = x1 * c0.y + x2 * c0.x;
        x1 = y2; x2 = y3; y2 = x1 * c1.x - x2 * c1.y; y3 = x1 * c1.y + x2 * c1.x;
        x1 = y4; x2 = y5; y4 = x1 * c2.x - x2 * c2.y; y5 = x1 * c2.y + x2 * c2.x;
        x1 = y6; x2 = y7; y6 = x1 * c3.x - x2 * c3.y; y7 = x1 * c3.y + x2 * c3.x; }
      u32x4 o_; o_.x = cvtpk(y0, y1); o_.y = cvtpk(y2, y3); o_.z = cvtpk(y4, y5); o_.w = cvtpk(y6, y7); qr[d0] = __builtin_bit_cast(bf16x8, o_); }
  }
  const int sr = tid >> 4, sc = (tid & 15) * 8, vst0 = v_st(sr, sc), vst1 = v_st(32 + sr, sc);
  const int vb0 = (int)(unsigned)(uintptr_t)V_lds + v_rd_base(lane);
  struct { bf16x8 vs0, vs1, ks0, ks1; } sr_[1];
  const unsigned vo0 = (unsigned)((sr * LDK + sc) * 2);
#define SLOAD(i, k0) do { const char* vt_ = (const char*)Vh + (size_t)(k0) * (LDK * 2); const char* kt_ = (const char*)Kh + (size_t)(k0) * (LDK * 2); \
    sr_[i].vs0 = *(const bf16x8*)(vt_ + vo0); sr_[i].vs1 = *(const bf16x8*)(vt_ + 32 * LDK * 2 + vo0); \
    sr_[i].ks0 = *(const bf16x8*)(kt_ + vo0); sr_[i].ks1 = *(const bf16x8*)(kt_ + 32 * LDK * 2 + vo0); } while (0)
#define SWRITE(b, i) do { *(LAS bf16x8*)(V_lds + (b) * SHM_V + vst0) = sr_[i].vs0;          \
    *(LAS bf16x8*)(V_lds + (b) * SHM_V + vst1) = sr_[i].vs1; int kc = sc * 2;               \
    *(LAS bf16x8*)(K_lds + (b) * SHM_K + KSWZ(sr, kc)) = sr_[i].ks0;                       \
    *(LAS bf16x8*)(K_lds + (b) * SHM_K + KSWZ(32 + sr, kc)) = sr_[i].ks1; } while (0)
#define SWAIT() asm volatile("s_waitcnt vmcnt(0)" ::: "memory")
#define RESC(a) do { if (__any((a) < 1.f)) { if (hi == 0) al_l[r32] = (a); asm volatile("s_waitcnt lgkmcnt(0)" ::: "memory"); \
    _Pragma("unroll") for (int d = 0; d < 4; ++d) _Pragma("unroll") for (int r = 0; r < 16; ++r) o[d][r] *= al_l[crow(r, hi)]; } } while (0)
  f32x16 pA0, pA1, pB0, pB1; float alA, alB; bf16x8 pa0, pa1, pa2, pa3; const int NT = seq / KVBLK;
  SLOAD(0, 0); asm volatile("s_waitcnt vmcnt(0)" ::: "memory"); SWRITE(0, 0); __syncthreads();
  qkt(pA0, pA1, K_lds, qr, negm, r32, hi); partialSM(pA0, pA1, m_reg, negm, alA);
  SLOAD(0, KVBLK);
  SWAIT(); SWRITE(1, 0); __syncthreads();
  for (int j = 1; j + 1 < NT; j += 2) {
    SBAR(); qkt(pB0, pB1, K_lds + SHM_K, qr, negm, r32, hi);
    finishSM(pA0, pA1, alA, l_reg, pa0, pa1, pa2, pa3); SBAR();
    SLOAD(0, (j + 1) * KVBLK); SBAR();
    pv_d0(o, vb0, pa0, pa1, pa2, pa3); partialSM(pB0, pB1, m_reg, negm, alB);
    __syncthreads(); SWAIT(); SWRITE(0, 0);
    RESC(alB); __syncthreads();
    SBAR(); qkt(pA0, pA1, K_lds, qr, negm, r32, hi);
    finishSM(pB0, pB1, alB, l_reg, pa0, pa1, pa2, pa3); SBAR();
    SLOAD(0, (j + 2) * KVBLK); SBAR();
    pv_d0(o, vb0 + (int)SHM_V, pa0, pa1, pa2, pa3); partialSM(pA0, pA1, m_reg, negm, alA);
    __syncthreads(); SWAIT(); SWRITE(1, 0);
    RESC(alA); __syncthreads();
  }
  SBAR(); qkt(pB0, pB1, K_lds + SHM_K, qr, negm, r32, hi);
  finishSM(pA0, pA1, alA, l_reg, pa0, pa1, pa2, pa3); SBAR();
  pv_d0(o, vb0, pa0, pa1, pa2, pa3); partialSM(pB0, pB1, m_reg, negm, alB);
  __syncthreads(); RESC(alB);
  finishSM(pB0, pB1, alB, l_reg, pa0, pa1, pa2, pa3); SBAR();
  pv_d0(o, vb0 + (int)SHM_V, pa0, pa1, pa2, pa3);
  if (hi == 0) li_l[r32] = l_reg; asm volatile("s_waitcnt lgkmcnt(0)" ::: "memory");
  float rli[16];
#pragma unroll
  for (int r = 0; r < 16; ++r) rli[r] = __builtin_amdgcn_rcpf(li_l[crow(r, hi)]);
  bf16_t* Ow = Ob + (long)(wid * QBLK) * LDO;
#pragma unroll
  for (int r = 0; r < 16; ++r) { int orow = crow(r, hi);
#pragma unroll
    for (int d0 = 0; d0 < 4; ++d0) Ow[(long)orow * LDO + d0 * 32 + r32] = f2bf(o[d0][r] * rli[r]); }
#undef SLOAD
#undef SWRITE
#undef SWAIT
#undef RESC
}
}

#define XB_TMO      128
#define XB_XCNT(j)  (256  + 64 * (j))
#define XB_XSUB(j)  (1280 + 64 * (j))
#define XB_XGEN(j)  (2304 + 64 * (j))
#define XB_TOP      3328
#define XB_TOPGEN   3392
#define XCD_BAR_WORDS 3456
#define XB_SPIN_CAP (1u << 18)

__device__ __forceinline__ unsigned xb_ld(unsigned* p)              { return __hip_atomic_load(p, __ATOMIC_RELAXED, __HIP_MEMORY_SCOPE_AGENT); }
__device__ __forceinline__ unsigned xb_add(unsigned* p, unsigned v) { return __hip_atomic_fetch_add(p, v, __ATOMIC_RELAXED, __HIP_MEMORY_SCOPE_AGENT); }
__device__ __forceinline__ unsigned xb_xcc_id() { return (unsigned)__builtin_amdgcn_s_getreg((3 << 11) | 20) & 0xFu; }
#define XB_SPIN(cond, bar) do { unsigned _sp = 0; while (cond) { __builtin_amdgcn_s_sleep(1); \
    if ((++_sp & 255u) == 0u) { if (xb_ld(&(bar)[XB_TMO])) break; if (_sp > XB_SPIN_CAP) { atomicAdd(&(bar)[XB_TMO], 1u); break; } } } } while (0)

struct XcdBarrier { unsigned* bar; unsigned x; volatile LAS unsigned* st; };

__device__ __forceinline__ XcdBarrier xcd_barrier_post(unsigned* bar, volatile LAS unsigned* st) {
    XcdBarrier b; b.bar = bar; b.x = xb_xcc_id(); b.st = st;
    if (threadIdx.x == 0) (void)xb_add(&bar[XB_XCNT(b.x)], 1u);
    return b;
}
__device__ __forceinline__ void xcd_barrier_complete(unsigned* bar, unsigned x, unsigned& nloc, unsigned& nx) {
    const unsigned G = gridDim.x * gridDim.y * gridDim.z;
    unsigned sum, cnt, mine, sp = 0u;
    for (;;) {
        sum = 0u; cnt = 0u; mine = 0u;
#pragma unroll
        for (unsigned j = 0; j < 16; ++j) { const unsigned c = xb_ld(&bar[XB_XCNT(j)]); sum += c; cnt += (c > 0u) ? 1u : 0u; mine = (j == x) ? c : mine; }
        if (sum == G) break;
        __builtin_amdgcn_s_sleep(1);
        if ((++sp & 255u) == 0u) { if (xb_ld(&bar[XB_TMO])) break; if (sp > XB_SPIN_CAP) { atomicAdd(&bar[XB_TMO], 1u); break; } }
    }
    nloc = mine > 0u ? mine : 1u; nx = cnt > 0u ? cnt : 1u;
}
__device__ __forceinline__ void xcd_barrier(const XcdBarrier& b) {
    asm volatile("s_waitcnt vmcnt(0)" ::: "memory");
    __syncthreads();
    if (threadIdx.x == 0) {
        unsigned* bar = b.bar;
        __builtin_amdgcn_s_waitcnt(0);
        unsigned nloc = b.st[0], nx = b.st[1];
        if (nloc == 0u) { xcd_barrier_complete(bar, b.x, nloc, nx); b.st[0] = nloc; b.st[1] = nx; }
        const unsigned old = xb_add(&bar[XB_XSUB(b.x)], 1u);
        const unsigned gen = old / nloc;
        if (old + 1u == (gen + 1u) * nloc) {
            __builtin_amdgcn_fence(__ATOMIC_RELEASE, "agent");
            asm volatile("s_waitcnt vmcnt(0)" ::: "memory");
            const unsigned og = xb_add(&bar[XB_TOP], 1u);
            const unsigned tg = og / nx;
            if (og + 1u == (tg + 1u) * nx) xb_add(&bar[XB_TOPGEN], 1u);
            else XB_SPIN(xb_ld(&bar[XB_TOPGEN]) == tg, bar);
            __builtin_amdgcn_fence(__ATOMIC_ACQUIRE, "agent");
            xb_add(&bar[XB_XGEN(b.x)], 1u);
            asm volatile("s_waitcnt vmcnt(0)" ::: "memory");
        } else {
            XB_SPIN(xb_ld(&bar[XB_XGEN(b.x)]) == gen, bar);
            __builtin_amdgcn_fence(__ATOMIC_ACQUIRE, "agent");
            asm volatile("s_waitcnt vmcnt(0)" ::: "memory");
        }
    }
    __syncthreads();
}

struct Args { const float* in[25]; float* out; unsigned char* ws; int ph_lo, ph_hi; };
enum { I_XP = 0, I_XS, I_CK, I_CV, I_C, I_CCTX, I_WMOD, I_BMOD, I_NMPRE, I_NMPOST, I_NFPRE, I_NFPOST, I_AWIN, I_ANV, I_AWS, I_ABS, I_AWOUT,
       I_BWQKV, I_BQN, I_BKN, I_BWO, I_CWP, I_CSC, I_FWGU, I_FWDN };
constexpr int NPHASE = 35;

__device__ __forceinline__ void tr_item(const float* W, int K, int N, bf16_t* WT, int mode, LAS float* scr, int item, int lane) {
    const int nblk = N / 32, kb = item / nblk, nb = item % nblk, k0 = 64 * kb, n0 = 32 * nb;
    int d0 = n0;
    if (mode == 1) d0 = n0 < FFH ? (n0 / 128) * 256 + (n0 % 128) : ((n0 - FFH) / 128) * 256 + 128 + ((n0 - FFH) % 128);
    float tv_[32];
#pragma unroll
    for (int i = 0; i < 32; ++i) { const int kk = 2 * i + (lane >> 5); tv_[i] = __builtin_nontemporal_load(W + (size_t)(k0 + kk) * N + n0 + (lane & 31)); }
#pragma unroll
    for (int i = 0; i < 32; ++i) { const int kk = 2 * i + (lane >> 5); scr[kk * 33 + (lane & 31)] = tv_[i]; }
    asm volatile("s_waitcnt lgkmcnt(0)" ::: "memory");
    const int c = lane & 7;
#pragma unroll
    for (int j = 0; j < 4; ++j) { const int n = (lane >> 3) + 8 * j; const LAS float* s = scr + (8 * c) * 33 + n;
        u32x4 o; o.x = cvt_pk_bf16(s[0 * 33], s[1 * 33]); o.y = cvt_pk_bf16(s[2 * 33], s[3 * 33]); o.z = cvt_pk_bf16(s[4 * 33], s[5 * 33]); o.w = cvt_pk_bf16(s[6 * 33], s[7 * 33]);
        __builtin_nontemporal_store(o, (u32x4*)(WT + (size_t)(d0 + n) * K + k0 + 8 * c)); }
    asm volatile("s_waitcnt lgkmcnt(0)" ::: "memory");
}
__device__ __forceinline__ void tr_matrix(const float* W, int K, int N, bf16_t* WT, int mode, LAS float* scr, int gw, int ngw, int lane) {
    const int nitems = (K / 64) * (N / 32);
    for (int it = gw; it < nitems; it += ngw) tr_item(W, K, N, WT, mode, scr, it, lane);
}

__global__ void __launch_bounds__(NTHR, 2) fwd(Args args) {
    extern __shared__ __attribute__((aligned(16))) unsigned char lds_raw[];
    LAS unsigned char* lds = (LAS unsigned char*)lds_raw;
    typedef const __attribute__((address_space(4))) unsigned char* kptr_t;
    const int G = gridDim.x, bid = blockIdx.x;
    const int vcu = __builtin_amdgcn_readfirstlane((G % 8 == 0) ? (bid % 8) * (G / 8) + bid / 8 : bid);
    const int lo = args.ph_lo, hi = args.ph_hi;
    {
        const int tid0 = threadIdx.x;
        for (int u = tid0; u < (LDS_BYTES - RING_BYTES) / 4; u += NTHR) ((LAS unsigned*)(lds + RING_BYTES))[u] = 0u;
        __syncthreads();
    }
    XcdBarrier bar; bar.bar = (unsigned*)(args.ws + WS_CTL) + CW_BAR; bar.x = 0; bar.st = (volatile LAS unsigned*)(lds + MISC_OFF + 32);
    if (hi - lo > 1) bar = xcd_barrier_post((unsigned*)(args.ws + WS_CTL) + CW_BAR, (volatile LAS unsigned*)(lds + MISC_OFF + 32));

#define KARG_IN(i) (*(const float* const __attribute__((address_space(4)))*)(kp + 8 * (i)))
#define PH_BEGIN(id) if (lo <= (id) && (id) < hi) { \
    kptr_t kp = (kptr_t)__builtin_amdgcn_kernarg_segment_ptr(); asm volatile("" : "+s"(kp)); \
    unsigned char* ws = *(unsigned char* const __attribute__((address_space(4)))*)(kp + 8 * 26); float* OUT = *(float* const __attribute__((address_space(4)))*)(kp + 8 * 25); \
    int tid = threadIdx.x; asm volatile("" : "+v"(tid)); const int lane = tid & 63, wave = __builtin_amdgcn_readfirstlane(tid >> 6); (void)lane; (void)wave; (void)OUT; (void)ws;
#define PH_END(id) if ((id) + 1 < hi) xcd_barrier(bar); }
#define MODP ((float*)(ws + WS_MODP))
#define MOD ((float*)(ws + WS_MOD))
#define ROPE ((f32x2*)(ws + WS_ROPE))
#define VSS ((float*)(ws + WS_VSS))
#define WGU ((bf16_t*)(ws + WS_WGU))
#define WDN ((bf16_t*)(ws + WS_WDN))
#define WIN ((bf16_t*)(ws + WS_WIN))
#define WOUT ((bf16_t*)(ws + WS_WOUT))
#define WQKV ((bf16_t*)(ws + WS_WQKV))
#define WO ((bf16_t*)(ws + WS_WO))
#define WPOOL ((bf16_t*)(ws + WS_WPOOL))
#define HB ((bf16_t*)(ws + WS_H))
#define MB ((bf16_t*)(ws + WS_MB))
#define BIG ((bf16_t*)(ws + WS_BIG))
#define UB BIG
#define VBUF ((bf16_t*)(ws + WS_BIG + BIG_V))
#define QB BIG
#define KRAW ((bf16_t*)(ws + WS_BIG + BIG_KR))
#define VRAW ((bf16_t*)(ws + WS_BIG + BIG_VR))
#define KB ((bf16_t*)(ws + WS_KB))
#define VB ((bf16_t*)(ws + WS_VB))
#define XB ((bf16_t*)(ws + WS_XB))

    PH_BEGIN(0)
    {
        const int gw = vcu * NWAVES + wave, ngw = G * NWAVES;
        LAS float* scr = (LAS float*)(lds + wave * 16384);
        for (int l = 0; l < 4; ++l) {
            tr_matrix(KARG_IN(I_FWGU) + (size_t)l * DM * 2 * FFH, DM, 2 * FFH, WGU + (size_t)l * 2 * FFH * DM, 1, scr, gw, ngw, lane);
            tr_matrix(KARG_IN(I_FWDN) + (size_t)l * FFH * DM, FFH, DM, WDN + (size_t)l * DM * FFH, 0, scr, gw, ngw, lane);
        }
        for (int l = 0; l < 2; ++l) {
            tr_matrix(KARG_IN(I_AWIN) + (size_t)l * DM * 2 * DM, DM, 2 * DM, WIN + (size_t)l * 2 * DM * DM, 0, scr, gw, ngw, lane);
            tr_matrix(KARG_IN(I_AWOUT) + (size_t)l * DM * DM, DM, DM, WOUT + (size_t)l * DM * DM, 0, scr, gw, ngw, lane);
        }
        tr_matrix(KARG_IN(I_BWQKV), DM, 3072, WQKV, 0, scr, gw, ngw, lane);
        tr_matrix(KARG_IN(I_BWO), DM, DM, WO, 0, scr, gw, ngw, lane);
        for (int gq = 0; gq < 4; ++gq) tr_matrix(KARG_IN(I_CWP) + (size_t)gq * 512 * 512, 512, 512, WPOOL + (size_t)gq * 512 * 512, 0, scr, gw, ngw, lane);
        __syncthreads();
        LAS float* sl = (LAS float*)lds;
        for (int i = tid; i < NCOND * DM; i += NTHR) { const int b = i / DM, k = i % DM; const float c = b == 0 ? KARG_IN(I_CCTX)[k] : KARG_IN(I_C)[(b - 1) * DM + k]; sl[i] = c / (1.0f + expf(-c)); }
        __syncthreads();
        for (int it = vcu; it < 4 * 24 * 8; it += G) {
            const int l = it / 192, cb = (it % 192) / 8, ks = it % 8, col = cb * 512 + tid;
            float acc[NCOND];
#pragma unroll
            for (int b = 0; b < NCOND; ++b) acc[b] = 0.f;
            const float* wp = KARG_IN(I_WMOD) + ((size_t)l * DM + ks * 256) * MODW + col;
#pragma unroll 8
            for (int k4 = 0; k4 < 64; ++k4) {
                const float w0 = __builtin_nontemporal_load(wp + (size_t)(4 * k4 + 0) * MODW), w1 = __builtin_nontemporal_load(wp + (size_t)(4 * k4 + 1) * MODW), w2 = __builtin_nontemporal_load(wp + (size_t)(4 * k4 + 2) * MODW), w3 = __builtin_nontemporal_load(wp + (size_t)(4 * k4 + 3) * MODW);
#pragma unroll
                for (int b = 0; b < NCOND; ++b) { const f32x4 s4 = *(const LAS f32x4*)(sl + b * DM + ks * 256 + 4 * k4); acc[b] += (s4[0] * w0 + s4[1] * w1) + (s4[2] * w2 + s4[3] * w3); }
            }
#pragma unroll
            for (int b = 0; b < NCOND; ++b) MODP[((size_t)(l * 8 + ks) * NCOND + b) * MODW + col] = acc[b];
        }
        for (size_t i = (size_t)bid * NTHR + tid; i < (size_t)2 * LAT_B * PAST * 64; i += (size_t)G * NTHR) {
            const int which = (int)(i / ((size_t)LAT_B * PAST * 64)); const size_t j = i % ((size_t)LAT_B * PAST * 64);
            const int b = (int)(j / (PAST * 64)), s = (int)((j / 64) % PAST), c8 = (int)(j % 64) * 8;
            const float* src = KARG_IN(which ? I_CV : I_CK) + ((size_t)(b * PAST + s) * 512 + c8);
            const f32x4 a = __builtin_nontemporal_load((const f32x4*)src), bb = __builtin_nontemporal_load((const f32x4*)(src + 4));
            u32x4 w; w.x = cvt_pk_bf16(a[0], a[1]); w.y = cvt_pk_bf16(a[2], a[3]); w.z = cvt_pk_bf16(bb[0], bb[1]); w.w = cvt_pk_bf16(bb[2], bb[3]);
            *(u32x4*)((which ? VB : KB) + ((size_t)(NCTX + b * KV_T + LAT_T + s) * 512 + c8)) = w;
        }
        if (bid == 0) for (int i = tid; i < 64 * 32; i += NTHR) { const int pos = i / 32, j = i % 32; const float inv = powf(10000.0f, -(float)(2 * j) / 64.0f); const float ang = (float)pos * inv;
            ROPE[i] = (f32x2){cosf(ang), sinf(ang)}; }
        __syncthreads();
    }
    PH_END(0)

    PH_BEGIN(1)
    for (int i = bid * NTHR + tid; i < 4 * NCOND * MODW; i += G * NTHR) {
        const int l = i / (NCOND * MODW), b = (i / MODW) % NCOND, j = i % MODW;
        float s = KARG_IN(I_BMOD)[l * MODW + j];
#pragma unroll
        for (int ks = 0; ks < 8; ++ks) s += MODP[((size_t)(l * 8 + ks) * NCOND + b) * MODW + j];
        MOD[i] = s;
    }
    PH_END(1)

    for (int l = 0; l <= 4; ++l) {
        const int kind = l % 3, ia = l / 3, pbase = 2 + 8 * l;
        for (int half = 0; half < 2; ++half) {
            if (half == 1 && l == 4) break;
            const int pid = half == 0 ? (l == 4 ? 34 : pbase) : pbase + 5;
            if (half == 1) {
                if (kind == 0) {
                    PH_BEGIN(pbase + 1)
                    { pg8::Gemm g{HB, WIN + (size_t)ia * 2 * DM * DM, DM, DM, DM, 31}; pg8::StaticOrder S; S.init(MTOK, 2 * DM, G, bid);
                      pg8::EpiUV E{UB, VBUF, VSS}; pg8::gemm_phase<pg8::EpiUV, pg8::StaticOrder>(lds, g, S, E, tid); }
                    PH_END(pbase + 1)
                    PH_BEGIN(pbase + 2)
                    {
                        constexpr int NUH = (MTOK / 128) * 16, W_OFF = 65536, W_STRIDE = 272, S_OFF = W_OFF + 128 * W_STRIDE, S_STRIDE = 264, BG_OFF = S_OFF + 128 * S_STRIDE, RS_OFF = BG_OFF + 1024, RSN = 16;
                        static_assert(RS_OFF + RSN * 512 <= MISC_OFF, "gate LDS map");
                        LAS float* rsb = (LAS float*)(lds + RS_OFF); LAS float* bgl = (LAS float*)(lds + BG_OFF);
                        const float* Ws = KARG_IN(I_AWS) + (size_t)ia * 8 * 128 * 128; const float* Bs = KARG_IN(I_ABS) + (size_t)ia * 8 * 128; const float* Gv = KARG_IN(I_ANV) + (size_t)ia * DM;
                        const int r32 = lane & 31, hh = lane >> 5, pr = wave & 3, eh = wave >> 2, wu = __builtin_amdgcn_readfirstlane(wave);
                        int voV[4];
#pragma unroll
                        for (int i = 0; i < 4; ++i) { const int j = (wu & 3) * 4 + i, blk = 2 * j + (lane >> 5), within = lane & 31, kk = (blk >> 2) * 8 + (within >> 2), c8 = (blk & 3) * 4 + (within & 3);
                            const int k = (kk & ~0xC) | ((kk & 4) << 1) | ((kk & 8) >> 1);
                            voV[i] = ((wu >> 2) * 64 + k) * DM + c8 * 8; }
#define GATE_DMA(SRC, VO, LOFF) do { _Pragma("unroll") for (int i_ = 0; i_ < 4; ++i_) \
                                __builtin_amdgcn_global_load_lds((const unsigned*)((SRC) + (VO)[i_]), (LAS unsigned*)(lds + (LOFF) + wu * 4096 + i_ * 1024), 16, 0, 0); } while (0)
#define GATE_BASE(UU) ((size_t)(((UU) >> 4) * 128) * DM + (((UU) >> 1) & 7) * 256 + ((UU) & 1) * 128)
                        int cur_key = -1, it = 0;
                        if (vcu < NUH) GATE_DMA(VBUF + GATE_BASE(vcu), voV, 0);
                        for (int u = vcu; u < NUH; u += G, ++it) {
                            const int gq = (u >> 1) & 7, hf = u & 1, un = u + G < NUH ? u + G : u; const size_t base = GATE_BASE(u);
                            const int itr = it % RSN;
                            if (itr == 0) {
#pragma unroll 1
                                for (int j = 0; j < RSN; ++j) { const int uu = u + j * G;
                                    if (uu < NUH) { const f32x4* vp4 = (const f32x4*)(VSS + (size_t)((uu >> 4) * 128 + (tid >> 2)) * 32) + (tid & 3) * 2; const f32x4 a0 = vp4[0], a1 = vp4[1];
                                        float sq = ((a0[0] + a0[1]) + (a0[2] + a0[3])) + ((a1[0] + a1[1]) + (a1[2] + a1[3])); sq += __shfl_xor(sq, 1); sq += __shfl_xor(sq, 2);
                                        if ((tid & 3) == 0) rsb[j * 128 + (tid >> 2)] = 1.0f / sqrtf(sq * (1.0f / DM) + EPS); } }
                            }
                            if ((u & 15) != cur_key) { cur_key = u & 15;
                                if (tid < 128) bgl[tid] = Bs[gq * 128 + tid]; else if (tid < 256) bgl[tid] = Gv[gq * 256 + hf * 128 + (tid - 128)];
                                const float* wrow = Ws + ((size_t)gq * 128 + (tid >> 2)) * 128 + (tid & 3) * 32;
#pragma unroll
                                for (int c = 0; c < 4; ++c) { const f32x4 wa = *(const f32x4*)(wrow + c * 8), wb = *(const f32x4*)(wrow + c * 8 + 4); u32x4 w;
                                    w.x = cvt_pk_bf16(wa[0], wa[1]); w.y = cvt_pk_bf16(wa[2], wa[3]); w.z = cvt_pk_bf16(wb[0], wb[1]); w.w = cvt_pk_bf16(wb[2], wb[3]);
                                    *(LAS u32x4*)(lds + W_OFF + (tid >> 2) * W_STRIDE + (tid & 3) * 64 + c * 16) = w; } }
                            if (it == 0) asm volatile("s_waitcnt vmcnt(0)" ::: "memory"); else asm volatile("s_waitcnt vmcnt(4)" ::: "memory");
                            asm volatile("s_waitcnt lgkmcnt(0)" ::: "memory"); __builtin_amdgcn_s_barrier(); asm volatile("" ::: "memory");
                            u32x4 uw[4];
#pragma unroll
                            for (int i_ = 0; i_ < 4; ++i_) { const int ci = tid + i_ * NTHR; uw[i_] = __builtin_nontemporal_load((const u32x4*)(UB + base + (size_t)(ci >> 4) * DM + (ci & 15) * 8)); }
                            asm volatile("" ::: "memory");
                            GATE_DMA(VBUF + GATE_BASE(un), voV, ((it + 1) & 1) * 32768);
                            asm volatile("" ::: "memory");
                            f32x16 o[2] = {};
                            const LAS float* rsc = rsb + itr * 128;
#pragma unroll
                            for (int kt = 0; kt < 2; ++kt) {
                                bf16x8 pa[4];
#pragma unroll
                                for (int s2 = 0; s2 < 4; ++s2) { const int q0 = kt * 64 + 16 * s2 + 8 * hh; const u32x4 wv = *(const LAS u32x4*)(lds + W_OFF + (32 * pr + r32) * W_STRIDE + q0 * 2);
                                    const f32x4 ra = *(const LAS f32x4*)(rsc + q0), rb = *(const LAS f32x4*)(rsc + q0 + 4);
                                    u32x4 w; w.x = cvt_pk_bf16(bflo(wv.x) * ra[0], bfhi(wv.x) * ra[1]); w.y = cvt_pk_bf16(bflo(wv.y) * ra[2], bfhi(wv.y) * ra[3]);
                                    w.z = cvt_pk_bf16(bflo(wv.z) * rb[0], bfhi(wv.z) * rb[1]); w.w = cvt_pk_bf16(bflo(wv.w) * rb[2], bfhi(wv.w) * rb[3]);
                                    pa[s2] = __builtin_bit_cast(bf16x8, w); }
                                const int vb = (int)(unsigned)(uintptr_t)(lds + (it & 1) * 32768 + kt * 16384) + att::v_rd_base(lane) + eh * 1024;
                                att::pv_one<0>(o[0], vb, pa[0], pa[1], pa[2], pa[3]); att::pv_one<1>(o[1], vb, pa[0], pa[1], pa[2], pa[3]);
                            }
                            { float gvr[2];
#pragma unroll
                              for (int i = 0; i < 2; ++i) gvr[i] = bgl[128 + eh * 64 + i * 32 + r32];
#pragma unroll
                              for (int r = 0; r < 16; ++r) { const int pp = 32 * pr + att::crow(r, hh); const float bs = bgl[pp];
#pragma unroll
                                for (int i = 0; i < 2; ++i) *(LAS unsigned short*)(lds + S_OFF + pp * S_STRIDE + (eh * 64 + i * 32 + r32) * 2) = f2bf(o[i][r] * gvr[i] + bs); } }
                            asm volatile("s_waitcnt lgkmcnt(0)" ::: "memory"); __builtin_amdgcn_s_barrier(); asm volatile("" ::: "memory");
#pragma unroll
                            for (int i_ = 0; i_ < 4; ++i_) { const int ci = tid + i_ * NTHR, pp_ = ci >> 4, ch = ci & 15;
                                const LAS u32x2* sp = (const LAS u32x2*)(lds + S_OFF + pp_ * S_STRIDE + ch * 16); const u32x2 s0 = sp[0], s1 = sp[1]; const u32x4 uq = uw[i_]; u32x4 ow;
                                ow.x = cvt_pk_bf16(bflo(uq.x) * bflo(s0.x), bfhi(uq.x) * bfhi(s0.x)); ow.y = cvt_pk_bf16(bflo(uq.y) * bflo(s0.y), bfhi(uq.y) * bfhi(s0.y));
                                ow.z = cvt_pk_bf16(bflo(uq.z) * bflo(s1.x), bfhi(uq.z) * bfhi(s1.x)); ow.w = cvt_pk_bf16(bflo(uq.w) * bflo(s1.y), bfhi(uq.w) * bfhi(s1.y));
                                *(u32x4*)(HB + base + (size_t)pp_ * DM + ch * 8) = ow; }
                        }
                        asm volatile("s_waitcnt vmcnt(0)" ::: "memory");
                        __syncthreads();
#undef GATE_DMA
#undef GATE_BASE
                    }
                    PH_END(pbase + 2)
                } else if (kind == 1) {
                    PH_BEGIN(pbase + 1)
                    { pg8::Gemm g{HB, WQKV, DM, DM, DM, 31}; pg8::StaticOrder S; S.init(MTOK, 3072, G, bid);
                      pg8::EpiQKV E{QB, KRAW, VB, OUT + OUT_SV}; pg8::gemm_phase<pg8::EpiQKV, pg8::StaticOrder>(lds, g, S, E, tid); }
                    PH_END(pbase + 1)
                    PH_BEGIN(pbase + 2)
                    {
                        const float* kn = KARG_IN(I_BKN);
                        for (int u = vcu; u < MTOK / 32; u += G) {
                            for (int rr = 0; rr < 4; ++rr) {
                                const int r = u * 32 + wave * 4 + rr; const bool lat = r >= NCTX;
                                int kvrow = r, prow = 0, pcol = 0;
                                if (lat) { const int b = (r - NCTX) >> 12, t = (r - NCTX) & 4095; kvrow = NCTX + b * KV_T + t; prow = t >> 6; pcol = t & 63; }
                                {
                                    const u32x4 w = __builtin_nontemporal_load((const u32x4*)(KRAW + (size_t)r * 512 + lane * 8)); float x[8];
                                    x[0] = bflo(w.x); x[1] = bfhi(w.x); x[2] = bflo(w.y); x[3] = bfhi(w.y); x[4] = bflo(w.z); x[5] = bfhi(w.z); x[6] = bflo(w.w); x[7] = bfhi(w.w);
                                    float ss = 0.f;
#pragma unroll
                                    for (int i = 0; i < 8; ++i) ss += x[i] * x[i];
                                    ss = row16_sum(ss);
                                    const float rstd = 1.0f / sqrtf(ss * (1.0f / 128.0f) + EPS); const int l16 = lane & 15;
#pragma unroll
                                    for (int i = 0; i < 8; ++i) x[i] = x[i] * rstd * kn[l16 * 8 + i];
                                    if (lat) { const f32x2* cs = ROPE + (l16 < 8 ? prow : pcol) * 32 + ((l16 * 4) & 31);
#pragma unroll
                                        for (int ii = 0; ii < 4; ++ii) { const f32x2 c = cs[ii]; const float x1 = x[2 * ii], x2 = x[2 * ii + 1]; x[2 * ii] = x1 * c.x - x2 * c.y; x[2 * ii + 1] = x1 * c.y + x2 * c.x; } }
                                    u32x4 o; o.x = cvt_pk_bf16(x[0], x[1]); o.y = cvt_pk_bf16(x[2], x[3]); o.z = cvt_pk_bf16(x[4], x[5]); o.w = cvt_pk_bf16(x[6], x[7]);
                                    *(u32x4*)(KB + (size_t)kvrow * 512 + lane * 8) = o;
                                    if (!lat) { float* sk = OUT + OUT_SK + (size_t)r * 512 + lane * 8; *(f32x4*)sk = (f32x4){x[0], x[1], x[2], x[3]}; *(f32x4*)(sk + 4) = (f32x4){x[4], x[5], x[6], x[7]}; }
                                }
                            }
                        }
                    }
                    PH_END(pbase + 2)
                    PH_BEGIN(pbase + 3)
                    {
                        char* ldsg = (char*)lds_raw;
                        for (int s = vcu; s < 2048 + 512; s += G) {
                            int qrow, kvrow0, h, kvh, seq, t0q;
                            if (s < 2048) {
                                int pidx, uip;
                                if (G == 256) { const int i = s >> 8, v = s & 255, x = v >> 5, j = v & 31; pidx = x * 4 + (i >> 1); uip = (i & 1) * 32 + j; } else { pidx = s >> 6; uip = s & 63; }
                                const int b = pidx >> 2, qb = uip & 15; kvh = pidx & 3; h = kvh * 4 + (uip >> 4);
                                qrow = NCTX + b * LAT_T + qb * 256; kvrow0 = NCTX + b * KV_T; seq = KV_T; t0q = qb * 256;
                            } else {
                                const int id = s - 2048, b = id >> 4; h = id & 15; kvh = h >> 2; qrow = b * 256; kvrow0 = qrow; seq = 256; t0q = -1;
                            }
                            const size_t qoff = (size_t)__builtin_amdgcn_readfirstlane(qrow) * DM + (size_t)__builtin_amdgcn_readfirstlane(h * 128);
                            const size_t koff = (size_t)__builtin_amdgcn_readfirstlane(kvrow0) * 512 + (size_t)__builtin_amdgcn_readfirstlane(kvh * 128);
                            seq = __builtin_amdgcn_readfirstlane(seq);
                            const bf16_t* qp = QB + qoff; bf16_t* op = HB + qoff; const bf16_t* kkp = KB + koff; const bf16_t* vp = VB + koff;
                            att::attn_dense_body(qp, kkp, vp, op, seq, (LAS char*)lds, tid, KARG_IN(I_BQN), ROPE, __builtin_amdgcn_readfirstlane(t0q));
                            __syncthreads();
                        }
                    }
                    PH_END(pbase + 3)
                } else {
                    PH_BEGIN(pbase + 1)
                    {
                        for (int u = vcu; u < MTOK / 32; u += G) {
                            const int r0 = u * 32 + wave * 4;
                            int base, T; if (r0 < NCTX) { base = r0 & ~255; T = 256; } else { base = NCTX + ((r0 - NCTX) & ~4095); T = LAT_T; }
                            const int t0 = r0 - base;
#define POOL_GRP(GI) { constexpr int W = 2 << (GI), HW = W / 2, NR = 3 + W; const int col = (GI) * 512 + lane * 8; u32x4 v[NR]; \
                                _Pragma("unroll") for (int i = 0; i < NR; ++i) { const int t = t0 - HW + i; v[i] = (t >= 0 && t < T) ? *(const u32x4*)(HB + (size_t)(base + t) * DM + col) : (u32x4){0u, 0u, 0u, 0u}; } \
                                _Pragma("unroll") for (int rr = 0; rr < 4; ++rr) { const int t = t0 + rr; const int lo_ = t - HW > 0 ? t - HW : 0, hi_ = t + HW < T ? t + HW : T; const float ic = 1.0f / (float)(hi_ - lo_); \
                                    float s[8] = {0.f, 0.f, 0.f, 0.f, 0.f, 0.f, 0.f, 0.f}; \
                                    _Pragma("unroll") for (int k = 0; k < W; ++k) { const u32x4 w = v[rr + k]; s[0] += bflo(w.x); s[1] += bfhi(w.x); s[2] += bflo(w.y); s[3] += bfhi(w.y); s[4] += bflo(w.z); s[5] += bfhi(w.z); s[6] += bflo(w.w); s[7] += bfhi(w.w); } \
                                    const u32x4 c = v[rr + HW]; u32x4 o; \
                                    o.x = cvt_pk_bf16(s[0] * ic - bflo(c.x), s[1] * ic - bfhi(c.x)); o.y = cvt_pk_bf16(s[2] * ic - bflo(c.y), s[3] * ic - bfhi(c.y)); \
                                    o.z = cvt_pk_bf16(s[4] * ic - bflo(c.z), s[5] * ic - bfhi(c.z)); o.w = cvt_pk_bf16(s[6] * ic - bflo(c.w), s[7] * ic - bfhi(c.w)); \
                                    *(u32x4*)(BIG + (size_t)(r0 + rr) * DM + col) = o; } }
                            POOL_GRP(0) POOL_GRP(1) POOL_GRP(2) POOL_GRP(3)
#undef POOL_GRP
                        }
                    }
                    PH_END(pbase + 1)
                }
                PH_BEGIN(pbase + 4)
                {
                    pg8::Gemm g; pg8::EpiM E{MB, DM, nullptr};
                    if (kind == 0) g = pg8::Gemm{HB, WOUT + (size_t)ia * DM * DM, DM, DM, DM, 31};
                    else if (kind == 1) g = pg8::Gemm{HB, WO, DM, DM, DM, 31};
                    else { g = pg8::Gemm{BIG, WPOOL, DM, 512, 512, 1}; E.cscale = KARG_IN(I_CSC); }
                    pg8::StaticOrder S; S.init(MTOK, DM, G, bid);
                    pg8::gemm_phase<pg8::EpiM, pg8::StaticOrder>(lds, g, S, E, tid);
                }
                PH_END(pbase + 4)
            }
            PH_BEGIN(pid)
            {
                const bool has_post = !(half == 0 && l == 0), has_pre = !(half == 0 && l == 4);
                const int lp = half == 0 ? l - 1 : l;
                const float* gate = MOD + (size_t)(lp < 0 ? 0 : lp) * NCOND * MODW + (half == 0 ? 5 : 2) * DM;
                const float* gpost = KARG_IN(half == 0 ? I_NFPOST : I_NMPOST) + (size_t)(lp < 0 ? 0 : lp) * DM;
                const int lq = l > 3 ? 3 : l;
                const float* shiftp = MOD + (size_t)lq * NCOND * MODW + (half == 0 ? 0 : 3) * DM;
                const float* scalep = MOD + (size_t)lq * NCOND * MODW + (half == 0 ? 1 : 4) * DM;
                const float* gpre = KARG_IN(half == 0 ? I_NMPRE : I_NFPRE) + (size_t)lq * DM;
                const bool x_from_in = (l == 0);
                LAS float* vec = (LAS float*)lds;
                int cur_c = -1;
                for (int u = vcu; u < MTOK / 32; u += G) {
                    const int rb = u * 32; const int c = rb < NCTX ? 0 : 1 + ((rb - NCTX) >> 12);
                    if (c != cur_c) {
                        __syncthreads();
                        { const int cc = 4 * tid, jv = cc >> 9, wi = cc & 511, ln = wi >> 3, hf = (wi & 7) >> 2, li = ((jv * 2 + hf) * 64 + ln) * 4;
                          f32x4 gav = {0.f, 0.f, 0.f, 0.f}, sbv = {0.f, 0.f, 0.f, 0.f}, shv = {0.f, 0.f, 0.f, 0.f};
                          if (has_post) gav = *(const f32x4*)(gate + (size_t)c * MODW + cc) * *(const f32x4*)(gpost + cc);
                          if (has_pre) { sbv = *(const f32x4*)(gpre + cc) * (*(const f32x4*)(scalep + (size_t)c * MODW + cc) + 1.0f); shv = *(const f32x4*)(shiftp + (size_t)c * MODW + cc); }
                          *(LAS f32x4*)(vec + li) = gav; *(LAS f32x4*)(vec + 2048 + li) = sbv; *(LAS f32x4*)(vec + 4096 + li) = shv; }
                        cur_c = c;
                        __syncthreads();
                    }
#define NR_UNPK(W, LO, HI) do { LO = (f32x4){bflo((W).x), bfhi((W).x), bflo((W).y), bfhi((W).y)}; HI = (f32x4){bflo((W).z), bfhi((W).z), bflo((W).w), bfhi((W).w)}; } while (0)
#define NR_ROW(X, MW, R) do { \
                        if (has_post) { float ss = 0.f; f32x4 mv[8]; \
                            _Pragma("unroll") for (int j = 0; j < 4; ++j) { NR_UNPK(MW[j], mv[2 * j], mv[2 * j + 1]); } \
                            _Pragma("unroll") for (int k = 0; k < 8; ++k) ss += (mv[k][0] * mv[k][0] + mv[k][1] * mv[k][1]) + (mv[k][2] * mv[k][2] + mv[k][3] * mv[k][3]); \
                            ss = wave_sum(ss); const float rstd = 1.0f / sqrtf(ss * (1.0f / DM) + EPS); \
                            _Pragma("unroll") for (int k = 0; k < 8; ++k) { const f32x4 gav = *(const LAS f32x4*)(vec + (k * 64 + lane) * 4); X[k] = X[k] + gav * (mv[k] * rstd); } \
                            if (has_pre) { _Pragma("unroll") for (int j = 0; j < 4; ++j) { u32x4 xw_; xw_.x = cvt_pk_bf16(X[2 * j][0], X[2 * j][1]); xw_.y = cvt_pk_bf16(X[2 * j][2], X[2 * j][3]); xw_.z = cvt_pk_bf16(X[2 * j + 1][0], X[2 * j + 1][1]); xw_.w = cvt_pk_bf16(X[2 * j + 1][2], X[2 * j + 1][3]); \
                                    __builtin_nontemporal_store(xw_, (u32x4*)(XB + (size_t)(R) * DM + 512 * j + 8 * lane)); } } \
                            else { _Pragma("unroll") for (int k = 0; k < 8; ++k) __builtin_nontemporal_store(X[k], (f32x4*)(OUT + (size_t)(R) * DM + 512 * (k >> 1) + 8 * lane + 4 * (k & 1))); } } \
                        if (has_pre) { float ss = 0.f; \
                            _Pragma("unroll") for (int k = 0; k < 8; ++k) ss += (X[k][0] * X[k][0] + X[k][1] * X[k][1]) + (X[k][2] * X[k][2] + X[k][3] * X[k][3]); \
                            ss = wave_sum(ss); const float rstd = 1.0f / sqrtf(ss * (1.0f / DM) + EPS); \
                            _Pragma("unroll") for (int j = 0; j < 4; ++j) { \
                                const f32x4 sb0 = *(const LAS f32x4*)(vec + 2048 + ((2 * j) * 64 + lane) * 4), sb1 = *(const LAS f32x4*)(vec + 2048 + ((2 * j + 1) * 64 + lane) * 4); \
                                const f32x4 sh0 = *(const LAS f32x4*)(vec + 4096 + ((2 * j) * 64 + lane) * 4), sh1 = *(const LAS f32x4*)(vec + 4096 + ((2 * j + 1) * 64 + lane) * 4); \
                                const f32x4 h0 = X[2 * j] * rstd * sb0 + sh0, h1 = X[2 * j + 1] * rstd * sb1 + sh1; u32x4 w_; \
                                w_.x = cvt_pk_bf16(h0[0], h0[1]); w_.y = cvt_pk_bf16(h0[2], h0[3]); w_.z = cvt_pk_bf16(h1[0], h1[1]); w_.w = cvt_pk_bf16(h1[2], h1[3]); \
                                *(u32x4*)(HB + (size_t)(R) * DM + 512 * j + 8 * lane) = w_; } } } while (0)
                    if (x_from_in) {
#pragma unroll 1
                        for (int pass = 0; pass < 2; ++pass) {
                            const int r = rb + wave * 4 + pass * 2;
                            f32x4 xa[8], xb[8]; u32x4 ma[4], mb[4];
                            const float* xr = r < NCTX ? KARG_IN(I_XP) + (size_t)r * DM : KARG_IN(I_XS) + (size_t)(r - NCTX) * DM;
#pragma unroll
                            for (int k = 0; k < 8; ++k) { xa[k] = __builtin_nontemporal_load((const f32x4*)(xr + 512 * (k >> 1) + 8 * lane + 4 * (k & 1))); xb[k] = __builtin_nontemporal_load((const f32x4*)(xr + DM + 512 * (k >> 1) + 8 * lane + 4 * (k & 1))); }
                            if (has_post) {
#pragma unroll
                                for (int j = 0; j < 4; ++j) { ma[j] = __builtin_nontemporal_load((const u32x4*)(MB + (size_t)r * DM + 512 * j + 8 * lane)); mb[j] = __builtin_nontemporal_load((const u32x4*)(MB + (size_t)(r + 1) * DM + 512 * j + 8 * lane)); }
                            } else {
#pragma unroll
                                for (int j = 0; j < 4; ++j) { ma[j] = (u32x4){0u, 0u, 0u, 0u}; mb[j] = (u32x4){0u, 0u, 0u, 0u}; }
                            }
                            NR_ROW(xa, ma, r); NR_ROW(xb, mb, r + 1);
                        }
                    } else {
                        const int r = rb + wave * 4;
                        u32x4 xw[4][4], mw[4][4];
#pragma unroll
                        for (int q = 0; q < 4; ++q)
#pragma unroll
                            for (int j = 0; j < 4; ++j) { xw[q][j] = __builtin_nontemporal_load((const u32x4*)(XB + (size_t)(r + q) * DM + 512 * j + 8 * lane)); mw[q][j] = __builtin_nontemporal_load((const u32x4*)(MB + (size_t)(r + q) * DM + 512 * j + 8 * lane)); }
#pragma unroll
                        for (int q = 0; q < 4; ++q) { f32x4 xa[8];
#pragma unroll
                            for (int j = 0; j < 4; ++j) NR_UNPK(xw[q][j], xa[2 * j], xa[2 * j + 1]);
                            NR_ROW(xa, mw[q], r + q); }
                    }
#undef NR_UNPK
#undef NR_ROW
                }
                __syncthreads();
            }
            PH_END(pid)
            if (half == 1) {
                PH_BEGIN(pbase + 6)
                { pg8::Gemm g{HB, WGU + (size_t)l * 2 * FFH * DM, DM, DM, DM, 31}; pg8::StaticOrder S; S.init(MTOK, 2 * FFH, G, bid);
                  pg8::EpiSwiglu E{BIG, FFH}; pg8::gemm_phase<pg8::EpiSwiglu, pg8::StaticOrder>(lds, g, S, E, tid); }
                PH_END(pbase + 6)
                PH_BEGIN(pbase + 7)
                { pg8::Gemm g{BIG, WDN + (size_t)l * DM * FFH, FFH, FFH, FFH, 31}; pg8::StaticOrder S; S.init(MTOK, DM, G, bid, 4);
                  pg8::EpiM E{MB, DM, nullptr}; pg8::gemm_phase<pg8::EpiM, pg8::StaticOrder>(lds, g, S, E, tid); }
                PH_END(pbase + 7)
            }
        }
    }
#undef PH_BEGIN
#undef PH_END
}

static bool phase_nonempty(int id) {
    if (id < 2 || id == 34) return true;
    const int l = (id - 2) / 8, k = (id - 2) % 8, kind = l % 3;
    if (k == 2) return kind != 2;
    if (k == 3) return kind == 1;
    return true;
}
extern "C" void kernel_launch(void* const* d_in, const int* in_sizes, int n_in, void* d_out, int out_size, void* d_ws, size_t ws_size, hipStream_t stream) {
    static int grid = 0;
    if (grid == 0) {
        if (n_in != 25 || ws_size < WS_END) { fprintf(stderr, "kernel_launch: expected 25 inputs and >= %zu bytes of workspace; got n_in %d ws %zu\n", (size_t)WS_END, n_in, ws_size); grid = -1; return; }
        int dev = 0, cus = 0, per_cu = 0;
        if (hipGetDevice(&dev) != hipSuccess || hipDeviceGetAttribute(&cus, hipDeviceAttributeMultiprocessorCount, dev) != hipSuccess) { grid = -1; return; }
        if (hipFuncSetAttribute((const void*)fwd, hipFuncAttributeMaxDynamicSharedMemorySize, LDS_BYTES) != hipSuccess) { fprintf(stderr, "kernel_launch: hipFuncSetAttribute failed\n"); grid = -1; return; }
        if (hipOccupancyMaxActiveBlocksPerMultiprocessor(&per_cu, (const void*)fwd, NTHR, LDS_BYTES) != hipSuccess || per_cu < 1) { fprintf(stderr, "kernel_launch: occupancy query says %d\n", per_cu); }
        (void)hipGetLastError();
        grid = cus;
    }
    if (grid < 0) return;
    (void)hipMemsetAsync((char*)d_ws + WS_CTL, 0, CTL_ZERO_BYTES, stream);
    Args a{};
    for (int i = 0; i < 25; ++i) a.in[i] = (const float*)d_in[i];
    a.out = (float*)d_out; a.ws = (unsigned char*)d_ws;
#if MK_ONE_LAUNCH
    a.ph_lo = 0; a.ph_hi = NPHASE;
    hipLaunchKernelGGL(fwd, dim3(grid), dim3(NTHR), LDS_BYTES, stream, a);
#else
    for (int id = 0; id < NPHASE; ++id) {
        if (!phase_nonempty(id)) continue;
        a.ph_lo = id; a.ph_hi = id + 1;
        hipLaunchKernelGGL(fwd, dim3(grid), dim3(NTHR), LDS_BYTES, stream, a);
    }
#endif
    const hipError_t le = hipPeekAtLastError();
    if (le != hipSuccess) fprintf(stderr, "kernel_launch: launch failed: %s\n", hipGetErrorName(le));
}
```
